# Optimizing an MI355X kernel written in HIP

```python
import math
import jax, jax.numpy as jnp
from jax import lax
import numpy as np

D_MODEL = 1024
BATCH = 8
SEQ = 2048
DEPTH = 4

CTX_LEN = 256
GRID_W = 64
EPS = 1e-6
NEG_INF = -1e9

HY_DIM = 256
HY_ORDER = 2
HY_SHORT = 3
HY_BANDS = 8
HY_POS_DIM = 1 + 2 * HY_BANDS
HY_FILT_HID = 64
HY_DECAY_TARGET = 1e-2
HY_FAST = 0.3
HY_SLOW = 1.5

NA_HEADS = 4
NA_HEAD_DIM = 64
NA_DIM = NA_HEADS * NA_HEAD_DIM
NA_WIN_ROWS = 8
NA_WIN_COLS = 16
NA_QCOLS = 16
NA_KCOLS = NA_QCOLS + NA_WIN_COLS
NA_NCB = GRID_W // NA_QCOLS

MLA_HEADS = 8
MLA_Q_RANK = 256
MLA_KV_RANK = 128
MLA_NOPE = 64
MLA_ROPE = 32
MLA_V = 64
MLA_QK = MLA_NOPE + MLA_ROPE
MLA_DIM = MLA_HEADS * MLA_V
MLA_QBLOCK = 128
ROPE_BASE = 10000.0
ROPE_FREQS = MLA_ROPE // 4

MIX_DIM = HY_DIM + NA_DIM + MLA_DIM
D_FF = 4 * D_MODEL
IN_HY = 3 * HY_DIM
IN_NA = 3 * NA_DIM
IN_MLA = MLA_Q_RANK + MLA_KV_RANK + MLA_ROPE
IN_DIM = IN_HY + IN_NA + IN_MLA

kernel_name = "hybrid_hyena_na_mla_prefix_dit"

F32 = jnp.float32


def _rms(x, g):
    xf = x.astype(F32)
    y = xf * lax.rsqrt(jnp.mean(xf * xf, axis=-1, keepdims=True) + EPS)
    return (y * g.astype(F32)).astype(x.dtype)


def _modulation(cond, w_mod, b_mod):
    m = jax.nn.silu(cond) @ w_mod + b_mod
    return jnp.split(m[:, None, :], 6, axis=-1)


def _adaln(h, g, shift, scale):
    return _rms(h, g) * (1.0 + scale) + shift


def _heads(t, n):
    b, l, _ = t.shape
    return t.reshape(b, l, n, -1).transpose(0, 2, 1, 3)


def _merge(t):
    b, n, l, d = t.shape
    return t.transpose(0, 2, 1, 3).reshape(b, l, n * d)


def _dense_attend(q, k, v):
    s = jnp.einsum('bhqd,bhkd->bhqk', q, k).astype(F32) * (q.shape[-1] ** -0.5)
    p = jax.nn.softmax(s, axis=-1).astype(v.dtype)
    return jnp.einsum('bhqk,bhkd->bhqd', p, v)


def _short_conv(u, w, b):
    y = lax.conv_general_dilated(u, w[:, None, :].astype(u.dtype), window_strides=(1,), padding='SAME',
                                 dimension_numbers=('NWC', 'WIO', 'NWC'), feature_group_count=u.shape[-1])
    return y + b


def _hyena_filters(L, w1, b1, w2, b2, w3, b3, freq):
    t = jnp.linspace(0.0, 1.0, L, dtype=F32)[:, None]
    w = (2.0 * math.pi / L) * jnp.arange(L, dtype=F32)[:, None]
    bands = jnp.linspace(1e-4, HY_BANDS - 1, HY_BANDS, dtype=F32)
    z = jnp.concatenate([t, jnp.cos(bands * w), -jnp.sin(bands * w)], axis=-1)
    freq = freq.astype(F32)
    hdn = jnp.sin(freq[0] * (z @ w1.astype(F32) + b1.astype(F32)))
    hdn = jnp.sin(freq[1] * (hdn @ w2.astype(F32) + b2.astype(F32)))
    h = (hdn @ w3.astype(F32) + b3.astype(F32)).reshape(L, HY_ORDER, 2, HY_DIM)
    deltas = jnp.linspace(math.log(HY_DECAY_TARGET) / HY_SLOW, math.log(HY_DECAY_TARGET) / HY_FAST,
                          HY_DIM, dtype=F32)
    decay = jnp.exp(-t * jnp.abs(deltas))
    h = h * decay[:, None, None, :]
    return h / (jnp.sum(jnp.abs(h), axis=(0, 2), keepdims=True) + EPS)


def _bidir_fftconv(u, h, bias):
    L, C = u.shape[1], u.shape[2]
    k = jnp.concatenate([h[:, 0], jnp.zeros((1, C), h.dtype), h[:0:-1, 1]], axis=0)
    uf = u.astype(F32)
    y = jnp.fft.irfft(jnp.fft.rfft(uf, n=2 * L, axis=1) * jnp.fft.rfft(k, axis=0), n=2 * L, axis=1)[:, :L]
    return (y + uf * bias.astype(F32)).astype(u.dtype)


def _hyena(p, conv_w, conv_b, filt, bias):
    p = _short_conv(p, conv_w, conv_b)
    v, x1, x2 = jnp.split(p, 3, axis=-1)
    z = v
    for o, gate in enumerate((x1, x2)):
        z = gate * _bidir_fftconv(z, filt[:, o], bias[o])
    return z


def _na_qkv(p, g_q, g_k):
    q, k, v = jnp.split(p, 3, axis=-1)
    return _rms(_heads(q, NA_HEADS), g_q), _rms(_heads(k, NA_HEADS), g_k), _heads(v, NA_HEADS)


def _na_latent(q, k, v, kc, vc, rpb):
    B, H, S, dh = q.shape
    R = S // GRID_W
    wr = min(NA_WIN_ROWS, R)
    r = jnp.arange(R)
    row_idx = jnp.clip(r - NA_WIN_ROWS // 2, 0, R - wr)[:, None] + jnp.arange(wr)
    qcol = jnp.arange(GRID_W).reshape(NA_NCB, NA_QCOLS)
    bstart = jnp.clip(jnp.arange(NA_NCB) * NA_QCOLS - NA_WIN_COLS // 2, 0, GRID_W - NA_KCOLS)
    col_idx = bstart[:, None] + jnp.arange(NA_KCOLS)
    ri = row_idx[:, None, :, None]
    ci = col_idx[None, :, None, :]

    def gather(t):
        tg = t.reshape(B, H, R, GRID_W, t.shape[-1])[:, :, ri, ci]
        return tg.reshape(B, H, R, NA_NCB, wr * NA_KCOLS, t.shape[-1])

    kb, vb = gather(k), gather(v)
    qg = q.reshape(B, H, R, NA_NCB, NA_QCOLS, dh)
    cstart = jnp.clip(qcol - NA_WIN_COLS // 2, 0, GRID_W - NA_WIN_COLS)
    kcol = col_idx[:, None, :]
    valid = (kcol >= cstart[..., None]) & (kcol < cstart[..., None] + NA_WIN_COLS)
    dr = row_idx - r[:, None] + NA_WIN_ROWS - 1
    dc = jnp.clip(kcol - qcol[..., None] + NA_WIN_COLS - 1, 0, 2 * NA_WIN_COLS - 2)
    bias = rpb.astype(F32)[:, dr[:, None, None, :, None], dc[None, :, :, None, :]]
    bias = jnp.where(valid[None, None, :, :, None, :], bias, NEG_INF)
    bias = bias.reshape(H, R, NA_NCB, NA_QCOLS, wr * NA_KCOLS)
    scale = dh ** -0.5
    s_loc = jnp.einsum('bhrjqd,bhrjkd->bhrjqk', qg, kb).astype(F32) * scale + bias[None]
    s_ctx = jnp.einsum('bhrjqd,bhcd->bhrjqc', qg, kc).astype(F32) * scale
    n_loc = s_loc.shape[-1]
    p = jax.nn.softmax(jnp.concatenate([s_loc, s_ctx], axis=-1), axis=-1).astype(v.dtype)
    o = (jnp.einsum('bhrjqk,bhrjkd->bhrjqd', p[..., :n_loc], vb)
         + jnp.einsum('bhrjqc,bhcd->bhrjqd', p[..., n_loc:], vc))
    return o.reshape(B, H, S, dh)


def _axial_rope_tables(S):
    t = jnp.arange(S)
    pos = jnp.stack([t // GRID_W, t % GRID_W], axis=-1).astype(F32)
    inv = ROPE_BASE ** (-jnp.arange(ROPE_FREQS, dtype=F32) / ROPE_FREQS)
    ang = pos[:, :, None] * inv
    return jnp.cos(ang), jnp.sin(ang)


def _axial_rope(x, cos, sin):
    xs = x.reshape(x.shape[:-1] + (2, 2, ROPE_FREQS))
    x1, x2 = xs[..., 0, :], xs[..., 1, :]
    c = cos[:, None].astype(x.dtype)
    s = sin[:, None].astype(x.dtype)
    return jnp.stack([x1 * c - x2 * s, x2 * c + x1 * s], axis=-2).reshape(x.shape)


def _mla_qkv(p, g_qa, g_kva, w_q_up, w_kv_up, g_q, g_k, rope):
    B, L, _ = p.shape
    cq, ckv, kr = jnp.split(p, [MLA_Q_RANK, MLA_Q_RANK + MLA_KV_RANK], axis=-1)
    q = (_rms(cq, g_qa) @ w_q_up).reshape(B, L, MLA_HEADS, MLA_QK)
    kv = (_rms(ckv, g_kva) @ w_kv_up).reshape(B, L, MLA_HEADS, MLA_NOPE + MLA_V)
    k = jnp.concatenate([kv[..., :MLA_NOPE],
                         jnp.broadcast_to(kr[:, :, None, :], (B, L, MLA_HEADS, MLA_ROPE))], axis=-1)
    v = kv[..., MLA_NOPE:]
    q = _rms(q, g_q)
    k = _rms(k, g_k)
    if rope is not None:
        cos, sin = rope
        q = jnp.concatenate([q[..., :MLA_NOPE], _axial_rope(q[..., MLA_NOPE:], cos, sin)], axis=-1)
        k = jnp.concatenate([k[..., :MLA_NOPE], _axial_rope(k[..., MLA_NOPE:], cos, sin)], axis=-1)
    return q.transpose(0, 2, 1, 3), k.transpose(0, 2, 1, 3), v.transpose(0, 2, 1, 3)


def _mla_latent(q, k, v, kc, vc):
    B, H, S, dq = q.shape
    kall = jnp.concatenate([k, kc], axis=2)
    vall = jnp.concatenate([v, vc], axis=2)
    nb = S // MLA_QBLOCK
    qb = q.reshape(B, H, nb, MLA_QBLOCK, dq).transpose(2, 0, 1, 3, 4)
    scale = dq ** -0.5

    def block(qi):
        s = jnp.einsum('bhqd,bhkd->bhqk', qi, kall).astype(F32) * scale
        return jnp.einsum('bhqk,bhkd->bhqd', jax.nn.softmax(s, axis=-1).astype(vall.dtype), vall)

    o = lax.map(block, qb)
    return o.transpose(1, 2, 0, 3, 4).reshape(B, H, S, v.shape[-1])


def _sqrelu_mlp(h, w1, b1, w2, b2):
    a = jax.nn.relu(h @ w1 + b1)
    return (a * a) @ w2 + b2


def setup_inputs(seed: int = 0) -> dict:
    key = jax.random.key(seed)
    ks = iter(jax.random.split(key, 40))

    def nrm(shape, scale):
        return jax.random.normal(next(ks), shape, F32) * scale

    def gain(shape):
        return 1.0 + nrm(shape, 0.02)

    L = DEPTH
    return {
        "x": nrm((BATCH, SEQ, D_MODEL), 1.0),
        "c": nrm((BATCH, D_MODEL), 1.0),
        "ctx": nrm((BATCH, CTX_LEN, D_MODEL), 1.0),
        "c_ctx": nrm((D_MODEL,), 1.0),
        "w_mod": nrm((L, D_MODEL, 6 * D_MODEL), 0.5 * D_MODEL ** -0.5),
        "b_mod": nrm((L, 6 * D_MODEL), 0.02),
        "g_norm1": gain((L, D_MODEL)),
        "w_in": nrm((L, D_MODEL, IN_DIM), D_MODEL ** -0.5),
        "hy_conv_w": nrm((L, HY_SHORT, IN_HY), HY_SHORT ** -0.5),
        "hy_conv_b": nrm((L, IN_HY), 0.02),
        "hy_f_w1": nrm((L, HY_POS_DIM, HY_FILT_HID), HY_POS_DIM ** -0.5),
        "hy_f_b1": nrm((L, HY_FILT_HID), 0.02),
        "hy_f_w2": nrm((L, HY_FILT_HID, HY_FILT_HID), HY_FILT_HID ** -0.5),
        "hy_f_b2": nrm((L, HY_FILT_HID), 0.02),
        "hy_f_w3": nrm((L, HY_FILT_HID, HY_ORDER * 2 * HY_DIM), HY_FILT_HID ** -0.5),
        "hy_f_b3": nrm((L, HY_ORDER * 2 * HY_DIM), 0.02),
        "hy_freq": gain((L, 2, HY_FILT_HID)),
        "hy_bias": nrm((L, HY_ORDER, HY_DIM), 0.5),
        "na_g_q": gain((L, NA_HEAD_DIM)),
        "na_g_k": gain((L, NA_HEAD_DIM)),
        "na_rpb": nrm((L, NA_HEADS, 2 * NA_WIN_ROWS - 1, 2 * NA_WIN_COLS - 1), 0.02),
        "mla_g_qa": gain((L, MLA_Q_RANK)),
        "mla_g_kva": gain((L, MLA_KV_RANK)),
        "mla_w_q_up": nrm((L, MLA_Q_RANK, MLA_HEADS * MLA_QK), MLA_Q_RANK ** -0.5),
        "mla_w_kv_up": nrm((L, MLA_KV_RANK, MLA_HEADS * (MLA_NOPE + MLA_V)), MLA_KV_RANK ** -0.5),
        "mla_g_q": gain((L, MLA_QK)),
        "mla_g_k": gain((L, MLA_QK)),
        "w_out": nrm((L, MIX_DIM, D_MODEL), MIX_DIM ** -0.5),
        "g_norm2": gain((L, D_MODEL)),
        "w_ff1": nrm((L, D_MODEL, D_FF), D_MODEL ** -0.5),
        "b_ff1": nrm((L, D_FF), 0.02),
        "w_ff2": nrm((L, D_FF, D_MODEL), D_FF ** -0.5),
        "b_ff2": nrm((L, D_MODEL), 0.02),
    }


def reference(x, c, ctx, c_ctx, w_mod, b_mod, g_norm1, w_in, hy_conv_w, hy_conv_b, hy_f_w1, hy_f_b1,
              hy_f_w2, hy_f_b2, hy_f_w3, hy_f_b3, hy_freq, hy_bias, na_g_q, na_g_k, na_rpb, mla_g_qa,
              mla_g_kva, mla_w_q_up, mla_w_kv_up, mla_g_q, mla_g_k, w_out, g_norm2, w_ff1, b_ff1, w_ff2, b_ff2):
    S = x.shape[1]
    Lc = ctx.shape[1]
    rope = _axial_rope_tables(S)
    cx = ctx
    for i in range(DEPTH):
        last = i == DEPTH - 1
        mx = _modulation(c, w_mod[i], b_mod[i])
        mc = _modulation(c_ctx[None], w_mod[i], b_mod[i])
        px = _adaln(x, g_norm1[i], mx[0], mx[1]) @ w_in[i]
        pc = _adaln(cx, g_norm1[i], mc[0], mc[1]) @ w_in[i]
        px_hy, px_na, px_mla = jnp.split(px, [IN_HY, IN_HY + IN_NA], axis=-1)
        pc_hy, pc_na, pc_mla = jnp.split(pc, [IN_HY, IN_HY + IN_NA], axis=-1)

        qx, kx, vx = _na_qkv(px_na, na_g_q[i], na_g_k[i])
        qc, kc, vc = _na_qkv(pc_na, na_g_q[i], na_g_k[i])
        o_na = _na_latent(qx, kx, vx, kc, vc, na_rpb[i])

        mqx, mkx, mvx = _mla_qkv(px_mla, mla_g_qa[i], mla_g_kva[i], mla_w_q_up[i], mla_w_kv_up[i],
                                 mla_g_q[i], mla_g_k[i], rope)
        mqc, mkc, mvc = _mla_qkv(pc_mla, mla_g_qa[i], mla_g_kva[i], mla_w_q_up[i], mla_w_kv_up[i],
                                 mla_g_q[i], mla_g_k[i], None)
        o_mla = _mla_latent(mqx, mkx, mvx, mkc, mvc)

        filt_x = _hyena_filters(S, hy_f_w1[i], hy_f_b1[i], hy_f_w2[i], hy_f_b2[i], hy_f_w3[i], hy_f_b3[i], hy_freq[i])
        o_hy = _hyena(px_hy, hy_conv_w[i], hy_conv_b[i], filt_x, hy_bias[i])

        mix = jnp.concatenate([o_hy, _merge(o_na), _merge(o_mla)], axis=-1) @ w_out[i]
        x = x + mx[2] * mix
        x = x + mx[5] * _sqrelu_mlp(_adaln(x, g_norm2[i], mx[3], mx[4]), w_ff1[i], b_ff1[i], w_ff2[i], b_ff2[i])

        if not last:
            filt_c = _hyena_filters(Lc, hy_f_w1[i], hy_f_b1[i], hy_f_w2[i], hy_f_b2[i], hy_f_w3[i], hy_f_b3[i],
                                    hy_freq[i])
            oc_hy = _hyena(pc_hy, hy_conv_w[i], hy_conv_b[i], filt_c, hy_bias[i])
            oc_na = _dense_attend(qc, kc, vc)
            oc_mla = _dense_attend(mqc, mkc, mvc)
            mix_c = jnp.concatenate([oc_hy, _merge(oc_na), _merge(oc_mla)], axis=-1) @ w_out[i]
            cx = cx + mc[2] * mix_c
            cx = cx + mc[5] * _sqrelu_mlp(_adaln(cx, g_norm2[i], mc[3], mc[4]), w_ff1[i], b_ff1[i], w_ff2[i],
                                          b_ff2[i])
    return x
```

```cpp
#include <hip/hip_runtime.h>
#include <hip/hip_cooperative_groups.h>
#include <cstdio>
#include <cstdint>
namespace cg = cooperative_groups;
#ifndef PROBE_MASK
#define PROBE_MASK 0
#endif
#define LAS __attribute__((address_space(3)))
typedef unsigned short bf16_t;
typedef short bf16x8 __attribute__((ext_vector_type(8)));
typedef float f32x4 __attribute__((ext_vector_type(4)));
typedef float f32x16 __attribute__((ext_vector_type(16)));
typedef unsigned u32x4 __attribute__((ext_vector_type(4)));
typedef unsigned u32x2 __attribute__((ext_vector_type(2)));

constexpr int DM = 1024, NB = 8, SEQ = 2048, DEPTH = 4, CTXL = 256, TOKB = SEQ + CTXL  ;
constexpr int NLAT = NB * SEQ  , NCTX = NB * CTXL  , NTOK = NLAT + NCTX  ;
constexpr int INP = 2048;
constexpr int DFF = 4096;
constexpr float EPSF = 1e-6f;
constexpr float LOG2E = 1.4426950408889634f;
constexpr int NTHREADS = 512;
constexpr int LDS_BYTES = 152 * 1024;

constexpr size_t MiB = (size_t)1 << 20;
constexpr size_t WS_MOD = 1 * MiB, WS_HDN2 = 2 * MiB, WS_ROPE = 5 * MiB, WS_W = 6 * MiB, W_LAYER = 23 * MiB;
constexpr size_t W_IN = 0, W_Q = 4 * MiB, W_KV = 4 * MiB + MiB / 2, W_OUT = 5 * MiB, W_FF1 = 7 * MiB, W_FF2 = 15 * MiB;
constexpr size_t WS_XC = 98 * MiB, WS_XN = 106 * MiB, WS_A = 142 * MiB;
constexpr size_t A_QP = 0, A_KN = 36 * MiB, A_PT = 72 * MiB, A_NAQ = 99 * MiB, A_NAK = 108 * MiB, A_NAVT = 117 * MiB;
constexpr size_t A_MIX = 146 * MiB, A_PART7 = 0, A_PART10 = 146 * MiB;
constexpr size_t WS_RSS1 = 512 * 1024, WS_RSS2 = 592 * 1024, WS_SW1 = 704 * 1024, WS_RSSDUMMY = 5 * 1024 * 1024 + 840 * 1024;
constexpr size_t A_CQ = 126 * MiB, A_OHYT = 126 * MiB, A_CKV = 135 * MiB, A_KR = 144 * MiB, A_MVT = 54 * MiB, A_MK = 182 * MiB, A_H = 0;
constexpr size_t WS_CQSS = WS_HDN2 + 2400 * 1024, WS_CKVSS = WS_HDN2 + 2480 * 1024;
constexpr size_t WS_KRSS = WS_HDN2 + 2560 * 1024;
constexpr size_t WS_KNSS = 360 * MiB;
constexpr size_t WS_SW2 = WS_ROPE + 256 * 1024;
constexpr size_t A_HYGL = 36 * MiB, A_HYGC = 46 * MiB;
constexpr size_t WS_KTAP = 352 * MiB;
constexpr size_t WS_END = 371 * MiB;

struct Args { const float* in[33]; float* out; unsigned char* ws; int ph_lo, ph_hi; int wv; };
enum { I_X = 0, I_C, I_CTX, I_CCTX, I_WMOD, I_BMOD, I_GN1, I_WIN, I_HCW, I_HCB, I_HW1, I_HB1, I_HW2, I_HB2, I_HW3, I_HB3, I_HFREQ, I_HBIAS,
       I_NAGQ, I_NAGK, I_RPB, I_GQA, I_GKVA, I_WQUP, I_WKVUP, I_MGQ, I_MGK, I_WOUT, I_GN2, I_WFF1, I_BFF1, I_WFF2, I_BFF2 };

namespace pg8 {
#define PG8_LAS __attribute__((address_space(3)))
typedef unsigned short bf16_t;
typedef short bf16x8 __attribute__((ext_vector_type(8)));
typedef float f32x4 __attribute__((ext_vector_type(4)));
typedef unsigned u32x4 __attribute__((ext_vector_type(4)));
constexpr int BM = 256, BK = 64, HALF = 128, HTB = HALF * BK * 2  , STAGE_BYTES = 8 * HTB, NXCD = 8, WGM = 8;

__host__ __device__ __forceinline__ int lds_byte(int r, int c) { const int st = (r >> 4) * 2 + (c >> 5), rr = r & 15, cc = c & 31, ob = rr * 64 + cc * 2; return st * 1024 + (ob ^ (((ob >> 9) & 1) << 5)); }
__host__ __device__ __forceinline__ void stage_rc(int b, int& R, int& C) { const int st = b / 1024, sb = b % 1024, swz = sb ^ (((sb >> 9) & 1) << 5); R = (st >> 1) * 16 + swz / 64; C = (st & 1) * 32 + (swz % 64) / 2; }
__host__ __device__ __forceinline__ int perm32(int rho) { const int n = rho >> 4, i = rho & 15; return 8 * (i >> 2) + 4 * n + (i & 3); }

struct Unit { const char* A; const char* B; int pm, pn, nt, sp, at, sub, kind; };
struct Gemm { const bf16_t* A; const bf16_t* Bt; int M, N, K; };

struct StaticOrder {
    int nM, nN, nwg, G, c;
    __host__ __device__ void init(int M, int N, int G_, int c_) { nM = M / BM; nN = N / BM; nwg = nM * nN; G = G_; c = c_; }
    __host__ __device__ bool next(int i, Unit& u) const {
        const long L = (long)i * G + c; if (L >= nwg) return false;
        int wgid = (int)L; { const int q = nwg / NXCD, r = nwg % NXCD, xcd = wgid % NXCD, off = wgid / NXCD; wgid = (xcd < r ? xcd * (q + 1) : r * (q + 1) + (xcd - r) * q) + off; }
        const int nig = WGM * nN, gid = wgid / nig, fm = gid * WGM, gsz = (nM - fm) < WGM ? (nM - fm) : WGM;
        u.pm = fm + ((wgid % nig) % gsz); u.pn = (wgid % nig) / gsz; return true;
    }
    __device__ __forceinline__ void a_ready(const Unit&) const {}
    __device__ __forceinline__ void done(const Unit&) const {}
};

__device__ __forceinline__ unsigned cvt_pk_bf16(float lo, float hi) { unsigned r; asm volatile("v_cvt_pk_bf16_f32 %0, %1, %2" : "=v"(r) : "v"(lo), "v"(hi)); return r; }
constexpr int NTOK_ = 18432, TOKB_ = 2304;
struct Sub { unsigned A, Bt; int M, N, kind; unsigned O; int ldc; unsigned rss; float rdiv; };
#if (PROBE_MASK >> 16) & 1
#define EPI_ATOMIC(p_, v_) do { const float hv_ = 0.5f * (v_); (void)__hip_atomic_fetch_add((p_), hv_, __ATOMIC_RELAXED, __HIP_MEMORY_SCOPE_AGENT); (void)__hip_atomic_fetch_add((p_), hv_, __ATOMIC_RELAXED, __HIP_MEMORY_SCOPE_AGENT); } while (0)
#else
#define EPI_ATOMIC(p_, v_) (void)__hip_atomic_fetch_add((p_), (v_), __ATOMIC_RELAXED, __HIP_MEMORY_SCOPE_AGENT)
#endif
struct EpiX {
    static constexpr bool PERM = true, AFTER_DRAIN = false;
    int mode;
    unsigned char* ws;
    unsigned oO0, oO1, oO2; int ldc0, ldc1, ldc2; unsigned orss0, orss1, orss2; float rdiv0, rdiv1, rdiv2;
    const float* bias;
    float* xlat;
    long long xdx;
    unsigned o_gate;
    unsigned o_sw; int ldsw;
    int xgf; const float* gn; unsigned o_gsc, o_rssout;
    unsigned o_part;
    unsigned o_cqss, o_ckvss;
    const float* gk;
    const float* nagq; const float* nagk;
    int knf;
    __device__ __forceinline__ void operator()(const f32x4 (&acc)[2][2][4][2], const Unit& u, int wr, int wc, int fr_in, int fq_in) const {
        (void)fr_in; (void)fq_in;
        unsigned ones_ = ~0u; asm volatile("" : "+s"(ones_));
        int lane_ = (int)__builtin_amdgcn_mbcnt_hi(ones_, __builtin_amdgcn_mbcnt_lo(ones_, 0u)); asm volatile("" : "+v"(lane_));
        const int fr = lane_ & 15, fq = lane_ >> 4;
#define EPI_SHX(v_, m_) __builtin_bit_cast(float, __builtin_amdgcn_ds_bpermute((lane_ ^ (m_)) << 2, __builtin_bit_cast(int, (float)(v_))))
        const int row0 = u.pm * BM + wr * 64 + fr;
        const int col0 = u.pn * BM + wc * 32 + 8 * fq;
        unsigned char* Ab = ws + WS_A;
        bf16_t* PT = (bf16_t*)(Ab + A_PT); bf16_t* NAVT = (bf16_t*)(Ab + A_NAVT); bf16_t* NAQ = (bf16_t*)(Ab + A_NAQ); bf16_t* NAK = (bf16_t*)(Ab + A_NAK); bf16_t* CQ = (bf16_t*)(Ab + A_CQ);
        bf16_t* CKV = (bf16_t*)(Ab + A_CKV); bf16_t* KR = (bf16_t*)(Ab + A_KR); bf16_t* MVT = (bf16_t*)(Ab + A_MVT);
        float* cqss = (float*)(ws + o_cqss); float* ckvss = (float*)(ws + o_ckvss); const float* rss1 = (const float*)(ws + WS_RSS1);
        const float* sw = (const float*)(ws + o_sw); float* xctx = (float*)(ws + WS_XC); const float* gate = (const float*)(ws + o_gate);
        bf16_t* xg = (bf16_t*)(ws + WS_XN); const float* gsc = (const float*)(ws + o_gsc); float* rss_out = (float*)(ws + o_rssout); float* part = (float*)(ws + o_part);
        if (u.kind == 1 || u.kind == 3) {
            const bool isv = u.kind == 3;
            const float* rsv = isv ? ckvss : rss1; const float rdv = isv ? (1.0f / 128.0f) : (1.0f / 1024.0f);
            const int cond = u.pn < 64 ? (u.pn >> 3) : 8;
            const int bsel = u.pn < 64 ? (u.pn >> 3) : (u.pn - 64), tok0 = u.pn < 64 ? (u.pn & 7) * 256 : 2048;
            f32x4 rs[2][2];
#pragma unroll
            for (int bj = 0; bj < 2; ++bj)
#pragma unroll
                for (int n = 0; n < 2; ++n) { const f32x4 q = *(const f32x4*)(rsv + col0 + bj * HALF + 4 * n);
#pragma unroll
                    for (int e4 = 0; e4 < 4; ++e4) rs[bj][n][e4] = __builtin_amdgcn_rsqf(q[e4] * rdv + 1e-6f); }
#pragma unroll
            for (int ai = 0; ai < 2; ++ai)
#pragma unroll
                for (int m = 0; m < 4; ++m) { const int rowc = row0 + ai * HALF + m * 16;
                    const float cbv = isv ? 0.f : sw[(size_t)cond * ldsw + rowc];
                    bf16_t* rowp;
                    if (isv) rowp = MVT + ((size_t)(bsel * 512 + rowc) * TOKB_ + tok0 + (col0 - u.pn * BM));
                    else if (u.pm < 3) rowp = PT + (size_t)rowc * NTOK_ + col0;
                    else rowp = NAVT + ((size_t)(bsel * 256 + (rowc - 768)) * TOKB_ + tok0 + (col0 - u.pn * BM));
#pragma unroll
                    for (int bj = 0; bj < 2; ++bj) { const f32x4 v0 = acc[ai][bj][m][0] * rs[bj][0] + cbv, v1 = acc[ai][bj][m][1] * rs[bj][1] + cbv;
                        u32x4 w; w.x = cvt_pk_bf16(v0[0], v0[1]); w.y = cvt_pk_bf16(v0[2], v0[3]); w.z = cvt_pk_bf16(v1[0], v1[1]); w.w = cvt_pk_bf16(v1[2], v1[3]);
                        *(u32x4*)(rowp + bj * HALF) = w; } }
            return;
        }
        if (u.kind == 2) {
            const int cond = u.pm < 64 ? (u.pm >> 3) : 8;
            const int bsel = u.pm < 64 ? (u.pm >> 3) : (u.pm - 64);
            f32x4 bv[2][2];
#pragma unroll
            for (int bj = 0; bj < 2; ++bj)
#pragma unroll
                for (int n = 0; n < 2; ++n) bv[bj][n] = *(const f32x4*)(sw + (size_t)cond * ldsw + 1024 + col0 + bj * HALF + 4 * n);
            const int cl = wc * 32 + 8 * fq;
#pragma unroll
            for (int ai = 0; ai < 2; ++ai)
#pragma unroll
                for (int m = 0; m < 4; ++m) { const int row = row0 + ai * HALF + m * 16;
                    const float rs = __builtin_amdgcn_rsqf(rss1[row] * (1.0f / 1024.0f) + 1e-6f);
                    const int tok = u.pm < 64 ? (row & 2047) : 2048 + (row & 255);
                    if (u.pn < 2) {
                        f32x4 v[2][2]; float ss = 0.f;
#pragma unroll
                        for (int bj = 0; bj < 2; ++bj)
#pragma unroll
                            for (int n = 0; n < 2; ++n) { v[bj][n] = acc[ai][bj][m][n] * rs + bv[bj][n]; const f32x4 t = v[bj][n]; ss += (t[0] * t[0] + t[1] * t[1]) + (t[2] * t[2] + t[3] * t[3]); }
                        ss += EPI_SHX(ss, 16); ss += EPI_SHX(ss, 32);
                        const float rn = __builtin_amdgcn_rsqf(ss * (1.0f / 64.0f) + 1e-6f) * (u.pn ? 1.0f : 0.125f * 1.4426950408889634f);
                        const float* gg = (u.pn ? nagk : nagq) + 8 * fq;
                        bf16_t* dst = (u.pn ? NAK : NAQ) + ((size_t)(bsel * 4 + wc) * TOKB_ + tok) * 64 + 8 * fq;
#pragma unroll
                        for (int bj = 0; bj < 2; ++bj) { const f32x4 v0 = v[bj][0] * *(const f32x4*)(gg + 32 * bj) * rn, v1 = v[bj][1] * *(const f32x4*)(gg + 32 * bj + 4) * rn;
                            u32x4 w; w.x = cvt_pk_bf16(v0[0], v0[1]); w.y = cvt_pk_bf16(v0[2], v0[3]); w.z = cvt_pk_bf16(v1[0], v1[1]); w.w = cvt_pk_bf16(v1[2], v1[3]);
                            *(u32x4*)(dst + 32 * bj) = w; }
                        continue; }
                    float ss0 = 0.f, ss1 = 0.f;
#pragma unroll
                    for (int bj = 0; bj < 2; ++bj) { const f32x4 v0 = acc[ai][bj][m][0] * rs + bv[bj][0], v1 = acc[ai][bj][m][1] * rs + bv[bj][1];
                        u32x4 w; w.x = cvt_pk_bf16(v0[0], v0[1]); w.y = cvt_pk_bf16(v0[2], v0[3]); w.z = cvt_pk_bf16(v1[0], v1[1]); w.w = cvt_pk_bf16(v1[2], v1[3]);
                        const float sq = ((v0[0] * v0[0] + v0[1] * v0[1]) + (v0[2] * v0[2] + v0[3] * v0[3])) + ((v1[0] * v1[0] + v1[1] * v1[1]) + (v1[2] * v1[2] + v1[3] * v1[3]));
                        if (bj == 0) ss0 = sq; else ss1 = sq;
                        const int cc = bj * HALF + cl;
                        if (u.pn == 2) { *(u32x4*)(CQ + (size_t)row * 256 + cc) = w; }
                        else { *(u32x4*)(CKV + (size_t)row * 256 + cc) = w;
                            if (bj == 1 && wc == 0) {
                                float kq = sq; kq += EPI_SHX(kq, 16); kq += EPI_SHX(kq, 32);
                                if (fq == 0) ((float*)(ws + WS_KRSS))[row] = kq;
                                const float* gkk = gk + 64 + 8 * fq; const f32x4 g0 = *(const f32x4*)gkk, g1 = *(const f32x4*)(gkk + 4);
                                f32x4 a0 = v0 * g0, a1 = v1 * g1;
                                f32x4 p0, p1;
#pragma unroll
                                for (int e4 = 0; e4 < 4; ++e4) { p0[e4] = EPI_SHX(a0[e4], 16); p1[e4] = EPI_SHX(a1[e4], 16); }
                                if (u.pm < 64) { const float* rp = (const float*)(ws + WS_ROPE) + (size_t)tok * 32 + (fq >> 1) * 8;
                                    const f32x4 c0 = *(const f32x4*)rp, c1 = *(const f32x4*)(rp + 4), s0 = *(const f32x4*)(rp + 16), s1 = *(const f32x4*)(rp + 20);
                                    if (fq & 1) { a0 = a0 * c0 + p0 * s0; a1 = a1 * c1 + p1 * s1; } else { a0 = a0 * c0 - p0 * s0; a1 = a1 * c1 - p1 * s1; } }
                                u32x4 wk; wk.x = cvt_pk_bf16(a0[0], a0[1]); wk.y = cvt_pk_bf16(a0[2], a0[3]); wk.z = cvt_pk_bf16(a1[0], a1[1]); wk.w = cvt_pk_bf16(a1[2], a1[3]);
                                *(u32x4*)(KR + (size_t)row * 32 + 8 * fq) = wk; } } }
                    if (u.pn >= 2) { float ss = u.pn == 2 ? ss0 + ss1 : ss0;
                        ss += EPI_SHX(ss, 16); ss += EPI_SHX(ss, 32);
                        if (fq == 0) EPI_ATOMIC((u.pn == 2 ? cqss : ckvss) + row, ss); } }
            return;
        }
        const unsigned k1 = 0u - (unsigned)(u.sub == 1), k2 = 0u - (unsigned)(u.sub == 2), k0 = ~(k1 | k2);
        const unsigned oO = (oO0 & k0) | (oO1 & k1) | (oO2 & k2); const int ldc = (int)(((unsigned)ldc0 & k0) | ((unsigned)ldc1 & k1) | ((unsigned)ldc2 & k2));
        const unsigned orss = (orss0 & k0) | (orss1 & k1) | (orss2 & k2);
        const float rdiv = __builtin_bit_cast(float, (__builtin_bit_cast(unsigned, rdiv0) & k0) | (__builtin_bit_cast(unsigned, rdiv1) & k1) | (__builtin_bit_cast(unsigned, rdiv2) & k2));
        bf16_t* O = (bf16_t*)(ws + oO); const float* rss = orss ? (const float*)(ws + orss) : nullptr;
        f32x4 bv[2][2];
#pragma unroll
        for (int bj = 0; bj < 2; ++bj)
#pragma unroll
            for (int n = 0; n < 2; ++n) bv[bj][n] = bias ? *(const f32x4*)(bias + col0 + bj * HALF + 4 * n) : (f32x4){0.f, 0.f, 0.f, 0.f};
        if (mode == 2) {
            const int cond = u.pm < 64 ? (u.pm >> 3) : 8;
            float* xb = u.pm < 64 ? xlat : (xctx - (size_t)16384 * 1024);
            f32x4 g[2][2];
#pragma unroll
            for (int bj = 0; bj < 2; ++bj)
#pragma unroll
                for (int n = 0; n < 2; ++n) g[bj][n] = *(const f32x4*)(gate + (size_t)cond * 6144 + col0 + bj * HALF + 4 * n);
            if (u.at) {
#pragma unroll
                for (int ai = 0; ai < 2; ++ai)
#pragma unroll
                    for (int m = 0; m < 4; ++m) { bf16_t* rowp = (bf16_t*)part + ((size_t)u.sp * 2048 + (size_t)(row0 + ai * HALF + m * 16 - 16384)) * 1024 + col0;
#pragma unroll
                        for (int bj = 0; bj < 2; ++bj) { const f32x4 v0 = acc[ai][bj][m][0], v1 = acc[ai][bj][m][1];
                            u32x4 w; w.x = cvt_pk_bf16(v0[0], v0[1]); w.y = cvt_pk_bf16(v0[2], v0[3]); w.z = cvt_pk_bf16(v1[0], v1[1]); w.w = cvt_pk_bf16(v1[2], v1[3]);
                            *(u32x4*)(rowp + bj * HALF) = w; } }
            } else if (!xgf) {
#pragma unroll
            for (int ai = 0; ai < 2; ++ai)
#pragma unroll
                for (int m = 0; m < 4; ++m) { float* rowp = xb + (size_t)(row0 + ai * HALF + m * 16) * 1024 + col0;
#pragma unroll
                    for (int bj = 0; bj < 2; ++bj)
#pragma unroll
                        for (int n = 0; n < 2; ++n) { f32x4* p = (f32x4*)(rowp + bj * HALF + 4 * n); const f32x4 xv = *(const f32x4*)((const char*)p + xdx); *p = xv + g[bj][n] * (acc[ai][bj][m][n] + bv[bj][n]); } }
            } else {
                f32x4 G[2][2];
#pragma unroll
                for (int bj = 0; bj < 2; ++bj)
#pragma unroll
                    for (int n = 0; n < 2; ++n) { const int cc = col0 + bj * HALF + 4 * n; G[bj][n] = *(const f32x4*)(gn + cc) * (*(const f32x4*)(gsc + (size_t)cond * 6144 + cc) + 1.0f); }
#pragma unroll
                for (int ai = 0; ai < 2; ++ai)
#pragma unroll
                    for (int m = 0; m < 4; ++m) { const int row = row0 + ai * HALF + m * 16; float* rowp = xb + (size_t)row * 1024 + col0; bf16_t* gp = xg + (size_t)row * 1024 + col0; float ss = 0.f;
#pragma unroll
                        for (int bj = 0; bj < 2; ++bj) { f32x4 xn[2];
#pragma unroll
                            for (int n = 0; n < 2; ++n) { f32x4* p = (f32x4*)(rowp + bj * HALF + 4 * n); const f32x4 xv = *(const f32x4*)((const char*)p + xdx); xn[n] = xv + g[bj][n] * (acc[ai][bj][m][n] + bv[bj][n]); *p = xn[n];
                                ss += (xn[n][0] * xn[n][0] + xn[n][1] * xn[n][1]) + (xn[n][2] * xn[n][2] + xn[n][3] * xn[n][3]); }
                            const f32x4 y0 = xn[0] * G[bj][0], y1 = xn[1] * G[bj][1];
                            u32x4 w; w.x = cvt_pk_bf16(y0[0], y0[1]); w.y = cvt_pk_bf16(y0[2], y0[3]); w.z = cvt_pk_bf16(y1[0], y1[1]); w.w = cvt_pk_bf16(y1[2], y1[3]);
                            *(u32x4*)(gp + bj * HALF) = w; }
                        ss += EPI_SHX(ss, 16); ss += EPI_SHX(ss, 32);
                        if (fq == 0) EPI_ATOMIC(rss_out + row, ss); }
            }
        } else {
            if (knf && u.sub == 1) {
                bf16_t* MK = (bf16_t*)(Ab + A_MK); const float* krss = (const float*)(ws + WS_KRSS);
                const int hh = u.pn * 4 + wc;
                f32x4 gg[2][2];
#pragma unroll
                for (int bj = 0; bj < 2; ++bj) { gg[bj][0] = *(const f32x4*)(gk + 32 * bj + 8 * fq); gg[bj][1] = *(const f32x4*)(gk + 32 * bj + 8 * fq + 4); }
#pragma unroll
                for (int ai = 0; ai < 2; ++ai)
#pragma unroll
                    for (int m = 0; m < 4; ++m) { const int row = row0 + ai * HALF + m * 16;
                        const float rs = __builtin_amdgcn_rsqf(rss[row] * rdiv + 1e-6f);
                        const u32x4 krw = *(const u32x4*)(KR + (size_t)row * 32 + 8 * fq);
                        const float krs = krss[row];
                        f32x4 v[2][2]; float kq = 0.f;
#pragma unroll
                        for (int bj = 0; bj < 2; ++bj)
#pragma unroll
                            for (int n = 0; n < 2; ++n) { v[bj][n] = acc[ai][bj][m][n] * rs; const f32x4 t = v[bj][n]; kq += (t[0] * t[0] + t[1] * t[1]) + (t[2] * t[2] + t[3] * t[3]); }
                        kq += EPI_SHX(kq, 16); kq += EPI_SHX(kq, 32);
                        const float rk = __builtin_amdgcn_rsqf((kq + krs) * (1.0f / 96.0f) + 1e-6f);
                        const int bb = u.pm < 64 ? (row >> 11) : ((row - 16384) >> 8), tok = u.pm < 64 ? (row & 2047) : 2048 + (row & 255);
                        bf16_t* dst = MK + ((size_t)(bb * 8 + hh) * TOKB_ + tok) * 96 + 8 * fq;
#pragma unroll
                        for (int bj = 0; bj < 2; ++bj) { const f32x4 v0 = v[bj][0] * gg[bj][0] * rk, v1 = v[bj][1] * gg[bj][1] * rk;
                            u32x4 w; w.x = cvt_pk_bf16(v0[0], v0[1]); w.y = cvt_pk_bf16(v0[2], v0[3]); w.z = cvt_pk_bf16(v1[0], v1[1]); w.w = cvt_pk_bf16(v1[2], v1[3]);
                            *(u32x4*)(dst + 32 * bj) = w; }
                        { u32x4 w;
                            w.x = cvt_pk_bf16(__builtin_bit_cast(float, krw.x << 16) * rk, __builtin_bit_cast(float, krw.x & 0xffff0000u) * rk); w.y = cvt_pk_bf16(__builtin_bit_cast(float, krw.y << 16) * rk, __builtin_bit_cast(float, krw.y & 0xffff0000u) * rk);
                            w.z = cvt_pk_bf16(__builtin_bit_cast(float, krw.z << 16) * rk, __builtin_bit_cast(float, krw.z & 0xffff0000u) * rk); w.w = cvt_pk_bf16(__builtin_bit_cast(float, krw.w << 16) * rk, __builtin_bit_cast(float, krw.w & 0xffff0000u) * rk);
                            *(u32x4*)(dst + 64) = w; } }
                return;
            }
            if (o_sw) { const int cond = u.pm < 64 ? (u.pm >> 3) : 8;
#pragma unroll
                for (int bj = 0; bj < 2; ++bj)
#pragma unroll
                    for (int n = 0; n < 2; ++n) bv[bj][n] = *(const f32x4*)(sw + (size_t)cond * ldsw + col0 + bj * HALF + 4 * n); }
#pragma unroll
            for (int ai = 0; ai < 2; ++ai)
#pragma unroll
                for (int m = 0; m < 4; ++m) { const int row = row0 + ai * HALF + m * 16; bf16_t* rowp = O + (size_t)row * ldc + col0;
                    const float rs = rss ? __builtin_amdgcn_rsqf(rss[row] * rdiv + 1e-6f) : 1.0f;
#pragma unroll
                    for (int bj = 0; bj < 2; ++bj) { f32x4 v0 = acc[ai][bj][m][0] * rs + bv[bj][0], v1 = acc[ai][bj][m][1] * rs + bv[bj][1];
                        if (mode == 1) {
#pragma unroll
                            for (int j = 0; j < 4; ++j) { const float a0 = v0[j] > 0.f ? v0[j] : 0.f, a1 = v1[j] > 0.f ? v1[j] : 0.f; v0[j] = a0 * a0; v1[j] = a1 * a1; } }
                        u32x4 w; w.x = cvt_pk_bf16(v0[0], v0[1]); w.y = cvt_pk_bf16(v0[2], v0[3]); w.z = cvt_pk_bf16(v1[0], v1[1]); w.w = cvt_pk_bf16(v1[2], v1[3]);
                        *(u32x4*)(rowp + bj * HALF) = w; } }
        }
    }
};

struct Order {
    const char* ws; unsigned A0, B0, A1, B1, A2, B2;
    int nM0, nN0, nM1, nN1, nM2, nN2, k0, k1, k2, n0, n1, n2, nMf, nrem, ksp, ntf, K, G, c;
    __device__ __forceinline__ void init(const char* ws_, const Sub& s0, const Sub& s1, const Sub& s2, int nsub, int K_, int ksplit, int G_, int c_) {
        ws = ws_; A0 = s0.A; B0 = s0.Bt; A1 = s1.A; B1 = s1.Bt; A2 = s2.A; B2 = s2.Bt; K = K_; ntf = K_ / BK; ksp = ksplit; G = G_; c = c_;
        nM0 = s0.M / BM; nN0 = s0.N / BM; k0 = s0.kind; nM1 = nsub > 1 ? s1.M / BM : 0; nN1 = nsub > 1 ? s1.N / BM : 1; k1 = s1.kind; nM2 = nsub > 2 ? s2.M / BM : 0; nN2 = nsub > 2 ? s2.N / BM : 1; k2 = s2.kind;
        nMf = (ksplit > 1 && nM0 > 64) ? 64 : nM0; n0 = nMf * nN0; nrem = (nM0 - nMf) * nN0; n1 = nM1 * nN1; n2 = nM2 * nN2;
    }
    static __device__ __forceinline__ void xmap(int L, int nM, int nN, int& pm, int& pn) {
        const int nwg = nM * nN; int wgid = L; { const int q = nwg / NXCD, r = nwg % NXCD, xcd = wgid % NXCD, off = wgid / NXCD; wgid = (xcd < r ? xcd * (q + 1) : r * (q + 1) + (xcd - r) * q) + off; }
        const int nig = WGM * nN, gid = wgid / nig, fm = gid * WGM, gsz = (nM - fm) < WGM ? (nM - fm) : WGM;
        pm = fm + ((wgid % nig) % gsz); pn = (wgid % nig) / gsz;
    }
    __device__ __forceinline__ bool next(int i_in, Unit& u) const {
        const bool swp = ksp > 1 && n0 == G && n1 == 0 && (nrem * ksp >= G ? (c & 1) : 1) && c < nrem * ksp && i_in < 2;
        const int i = swp ? 1 - i_in : i_in;
        const int L = i * G + c;
        int pm = 0, pn = 0, kb = 0, nt = ntf, sp = 0, at = 0, sub = 0, kind = k0; bool ok = true;
        if (L < n0) xmap(L, nMf, nN0, pm, pn);
        else if (L < n0 + n1) { sub = 1; kind = k1; xmap(L - n0, nM1, nN1, pm, pn); }
        else if (L < n0 + n1 + n2) { sub = 2; kind = k2; xmap(L - n0 - n1, nM2, nN2, pm, pn); }
        else { const int s = L - n0 - n1 - n2; ok = s < nrem * ksp;
            const int tile = s / ksp; sp = s % ksp; pm = nMf + tile / nN0; pn = tile % nN0; nt = ntf / ksp; kb = sp * nt; at = 1; }
        const unsigned k1m = 0u - (unsigned)(sub == 1), k2m = 0u - (unsigned)(sub == 2), k0m = ~(k1m | k2m);
        const unsigned Ao = (A0 & k0m) | (A1 & k1m) | (A2 & k2m), Bo = (B0 & k0m) | (B1 & k1m) | (B2 & k2m);
        u.A = ws + Ao + ((size_t)pm * BM * K + (size_t)kb * BK) * 2; u.B = ws + Bo + ((size_t)pn * BM * K + (size_t)kb * BK) * 2;
        u.pm = pm; u.pn = pn; u.nt = nt; u.sp = sp; u.at = at; u.sub = sub; u.kind = kind;
        return ok;
    }
    __device__ __forceinline__ void a_ready(const Unit&) const {}
    __device__ __forceinline__ void done(const Unit&) const {}
};

template <class Epi, class Sched, bool ALIGN_EPI = false, bool SP2 = false>
__device__ __forceinline__ void gemm_phase(PG8_LAS unsigned char* lds, const Gemm g, const Sched& S, const Epi& E) {
    unsigned ones_t = ~0u; asm volatile("" : "+s"(ones_t)); int tid_ = g.M * 64 + (int)__builtin_amdgcn_mbcnt_hi(ones_t, __builtin_amdgcn_mbcnt_lo(ones_t, 0u)); asm volatile("" : "+v"(tid_)); const int tid = tid_, wid = __builtin_amdgcn_readfirstlane(tid >> 6), lane = tid & 63, wr = wid >> 2, wc = wid & 3, fr = lane & 15, fq = lane >> 4;
    const int K = g.K;
    unsigned voffA[2], voffB[2];
#pragma unroll
    for (int i = 0; i < 2; ++i) { int R, C; stage_rc(tid * 16 + i * 8192, R, C); const int Rb = Epi::PERM ? ((R & ~31) + perm32(R & 31)) : R;
        voffA[i] = (unsigned)(R * K + C) * 2u; voffB[i] = (unsigned)(Rb * K + C) * 2u; }
    const size_t kstep = (size_t)(BK * 2);
    const size_t hstep = (size_t)HALF * K * 2;
    const size_t tstep = 2 * hstep;
    const unsigned ldsw = (unsigned)wid * 1024u;
    const int aoff = lds_byte(wr * 64 + fr, fq * 8), boff = lds_byte(wc * 32 + fr, fq * 8);
#define PG8_SA(b, h) (((b) * 2 + (h)) * HTB)
#define PG8_SB(b, h) ((4 + (b) * 2 + (h)) * HTB)
#define PG8_STAGE(bufoff, gbase, voff) do { _Pragma("unroll") for (int _i = 0; _i < 2; ++_i) \
        __builtin_amdgcn_global_load_lds((const unsigned*)((const char*)(gbase) + (voff)[_i]), (PG8_LAS unsigned*)(lds + (bufoff) + ldsw + _i * 8192), 16, 0, 0); } while (0)
#define PG8_LDA(dst, b, h) do { _Pragma("unroll") for (int m = 0; m < 4; ++m) _Pragma("unroll") for (int k = 0; k < 2; ++k) dst[m][k] = *(const PG8_LAS bf16x8*)(lds + PG8_SA(b, h) + aoff + m * 2048 + k * 1024); } while (0)
#define PG8_LDB(dst, b, h) do { _Pragma("unroll") for (int n = 0; n < 2; ++n) _Pragma("unroll") for (int k = 0; k < 2; ++k) dst[n][k] = *(const PG8_LAS bf16x8*)(lds + PG8_SB(b, h) + boff + n * 2048 + k * 1024); } while (0)
#define PG8_MMA(ai, bj, At, Bt) do { __builtin_amdgcn_s_setprio(1); _Pragma("unroll") for (int m = 0; m < 4; ++m) _Pragma("unroll") for (int n = 0; n < 2; ++n) _Pragma("unroll") for (int k = 0; k < 2; ++k) \
        acc[ai][bj][m][n] = __builtin_amdgcn_mfma_f32_16x16x32_bf16(Bt[n][k], At[m][k], acc[ai][bj][m][n], 0, 0, 0); __builtin_amdgcn_s_setprio(0); } while (0)
#define PG8_WAIT_V(n) asm volatile("s_waitcnt vmcnt(" #n ")" ::: "memory")
#define PG8_WAIT_L(n) asm volatile("s_waitcnt lgkmcnt(" #n ")" ::: "memory")
#define PG8_BAR __builtin_amdgcn_s_barrier()
#define PG8_SCHED __builtin_amdgcn_sched_barrier(0)
    Unit cur, nxt; int ui = 0;
    if (!S.next(0, cur)) return;
    f32x4 acc[2][2][4][2];
#pragma unroll
    for (int a = 0; a < 2; ++a)
#pragma unroll
        for (int b = 0; b < 2; ++b)
#pragma unroll
            for (int m = 0; m < 4; ++m)
#pragma unroll
                for (int n = 0; n < 2; ++n) acc[a][b][m][n] = (f32x4){0.f, 0.f, 0.f, 0.f};
    bf16x8 At[4][2], B0[2][2], B1[2][2];
    const char* cA = cur.A; const char* cB = cur.B;
    S.a_ready(cur);
    if constexpr (SP2) {
        PG8_STAGE(PG8_SB(0, 0), cB, voffB); PG8_STAGE(PG8_SB(0, 1), cB + hstep, voffB); PG8_STAGE(PG8_SA(0, 0), cA, voffA); PG8_STAGE(PG8_SA(0, 1), cA + hstep, voffA);
        if (wr == 1) PG8_BAR;
        PG8_WAIT_V(2); PG8_BAR;
        PG8_STAGE(PG8_SB(1, 0), cB + kstep, voffB); PG8_STAGE(PG8_SA(1, 0), cA + kstep, voffA); PG8_STAGE(PG8_SB(1, 1), cB + hstep + kstep, voffB);
        PG8_WAIT_V(6); PG8_BAR;
    } else {
        PG8_STAGE(PG8_SB(0, 0), cB, voffB); PG8_STAGE(PG8_SA(0, 0), cA, voffA); PG8_STAGE(PG8_SB(0, 1), cB + hstep, voffB); PG8_STAGE(PG8_SA(0, 1), cA + hstep, voffA);
        if (wr == 1) PG8_BAR;
        PG8_WAIT_V(4); PG8_BAR;
        PG8_STAGE(PG8_SB(1, 0), cB + kstep, voffB); PG8_STAGE(PG8_SA(1, 0), cA + kstep, voffA); PG8_STAGE(PG8_SB(1, 1), cB + hstep + kstep, voffB);
        PG8_WAIT_V(6); PG8_BAR;
    }
    for (;;) {
        const bool has_next = S.next(ui + 1, nxt);
        const char* nA = has_next ? nxt.A : cA; const char* nB = has_next ? nxt.B : cB;
        const int nt = cur.nt;
        for (int t = 0; t < nt; t += 2) {
            const bool last = (t == nt - 2);
            const char* a1 = cA + (size_t)(t + 1) * kstep;
            const char* a2 = last ? nA : cA + (size_t)(t + 2) * kstep; const char* b2 = last ? nB : cB + (size_t)(t + 2) * kstep;
            const char* a3 = a2 + kstep; const char* b3 = b2 + kstep;
            if (last && has_next) S.a_ready(nxt);
            if constexpr (SP2) {
            PG8_LDB(B0, 0, 0); PG8_LDB(B1, 0, 1); PG8_SCHED; PG8_LDA(At, 0, 0); PG8_STAGE(PG8_SA(1, 1), a1 + hstep, voffA);
            PG8_WAIT_V(8); PG8_WAIT_L(0); PG8_BAR; PG8_MMA(0, 0, At, B0); PG8_MMA(0, 1, At, B1); PG8_BAR; PG8_SCHED;
            PG8_LDA(At, 0, 1); PG8_STAGE(PG8_SB(0, 0), b2, voffB); PG8_STAGE(PG8_SB(0, 1), b2 + hstep, voffB); PG8_STAGE(PG8_SA(0, 0), a2, voffA);
            PG8_WAIT_V(8); PG8_WAIT_L(0); PG8_BAR; PG8_MMA(1, 0, At, B0); PG8_MMA(1, 1, At, B1); PG8_BAR; PG8_SCHED;
            PG8_LDB(B0, 1, 0); PG8_LDB(B1, 1, 1); PG8_SCHED; PG8_LDA(At, 1, 0); PG8_STAGE(PG8_SA(0, 1), a2 + hstep, voffA);
            PG8_WAIT_V(8); PG8_WAIT_L(0); PG8_BAR; PG8_MMA(0, 0, At, B0); PG8_MMA(0, 1, At, B1); PG8_BAR; PG8_SCHED;
            PG8_LDA(At, 1, 1); PG8_STAGE(PG8_SB(1, 0), b3, voffB); PG8_STAGE(PG8_SB(1, 1), b3 + hstep, voffB); PG8_STAGE(PG8_SA(1, 0), a3, voffA);
            PG8_WAIT_V(8); PG8_WAIT_L(0); PG8_BAR; PG8_MMA(1, 0, At, B0); PG8_MMA(1, 1, At, B1); PG8_BAR; PG8_SCHED;
            } else {
            PG8_LDB(B0, 0, 0); PG8_SCHED; PG8_LDA(At, 0, 0); PG8_STAGE(PG8_SA(1, 1), a1 + hstep, voffA);
            PG8_WAIT_L(8); PG8_BAR; PG8_WAIT_L(0); PG8_MMA(0, 0, At, B0); PG8_BAR; PG8_SCHED;
            PG8_LDB(B1, 0, 1); PG8_STAGE(PG8_SB(0, 0), b2, voffB);
            PG8_BAR; PG8_WAIT_L(0); PG8_MMA(0, 1, At, B1); PG8_BAR;
            PG8_LDA(At, 0, 1); PG8_STAGE(PG8_SA(0, 0), a2, voffA);
            PG8_BAR; PG8_WAIT_L(0); PG8_MMA(1, 0, At, B0); PG8_BAR; PG8_SCHED;
            PG8_STAGE(PG8_SB(0, 1), b2 + hstep, voffB);
            PG8_WAIT_V(6); PG8_BAR; PG8_MMA(1, 1, At, B1); PG8_BAR;
            PG8_LDB(B0, 1, 0); PG8_SCHED; PG8_LDA(At, 1, 0); PG8_STAGE(PG8_SA(0, 1), a2 + hstep, voffA);
            PG8_WAIT_L(8); PG8_BAR; PG8_WAIT_L(0); PG8_MMA(0, 0, At, B0); PG8_BAR; PG8_SCHED;
            PG8_LDB(B1, 1, 1); PG8_STAGE(PG8_SB(1, 0), b3, voffB);
            PG8_BAR; PG8_WAIT_L(0); PG8_MMA(0, 1, At, B1); PG8_BAR;
            PG8_LDA(At, 1, 1); PG8_STAGE(PG8_SA(1, 0), a3, voffA);
            PG8_BAR; PG8_WAIT_L(0); PG8_MMA(1, 0, At, B0); PG8_BAR; PG8_SCHED;
            PG8_STAGE(PG8_SB(1, 1), b3 + hstep, voffB);
            PG8_WAIT_V(6); PG8_BAR; PG8_MMA(1, 1, At, B1); PG8_BAR;
            }
        }
        if constexpr (ALIGN_EPI) { if (wr == 0) PG8_BAR; }
        if constexpr (!Epi::AFTER_DRAIN) { E(acc, cur, wr, wc, fr, fq); S.done(cur); }
        if (!has_next) break;
#pragma unroll
        for (int a = 0; a < 2; ++a)
#pragma unroll
            for (int b = 0; b < 2; ++b)
#pragma unroll
                for (int m = 0; m < 4; ++m)
#pragma unroll
                    for (int n = 0; n < 2; ++n) acc[a][b][m][n] = (f32x4){0.f, 0.f, 0.f, 0.f};
        cur = nxt; cA = nA; cB = nB; ++ui;
        if constexpr (ALIGN_EPI) { if (wr == 1) PG8_BAR; }
    }
    PG8_WAIT_V(0);
    if constexpr (!ALIGN_EPI) { if (wr == 0) PG8_BAR; }
    PG8_BAR;
    if constexpr (Epi::AFTER_DRAIN) { E.fused(acc, cur, wr, wc, fr, fq, lds, wid, lane); S.done(cur); }
#undef PG8_SA
#undef PG8_SB
#undef PG8_STAGE
#undef PG8_LDA
#undef PG8_LDB
#undef PG8_MMA
#undef PG8_WAIT_V
#undef PG8_WAIT_L
#undef PG8_BAR
#undef PG8_SCHED
}
}

__device__ __forceinline__ unsigned f2bf(float f) { unsigned u = __builtin_bit_cast(unsigned, f); return (u + 0x7fffu + ((u >> 16) & 1u)) >> 16; }
typedef float f32x2_t __attribute__((ext_vector_type(2))); typedef __bf16 bf16x2_t __attribute__((ext_vector_type(2)));
__device__ __forceinline__ unsigned pk2(float lo, float hi) { f32x2_t v = {lo, hi}; bf16x2_t b = __builtin_convertvector(v, bf16x2_t); return __builtin_bit_cast(unsigned, b); }
__device__ __forceinline__ float bf2f(unsigned h) { return __builtin_bit_cast(float, h << 16); }
__device__ __forceinline__ float bflo(unsigned w) { return __builtin_bit_cast(float, w << 16); }
__device__ __forceinline__ float bfhi(unsigned w) { return __builtin_bit_cast(float, w & 0xffff0000u); }
template <int M> __device__ __forceinline__ float xpart(float v) {
    const int u = __builtin_bit_cast(int, v);
    if constexpr (M == 1) return __builtin_bit_cast(float, __builtin_amdgcn_update_dpp(u, u, 0xB1, 0xF, 0xF, false));
    else if constexpr (M == 2) return __builtin_bit_cast(float, __builtin_amdgcn_update_dpp(u, u, 0x4E, 0xF, 0xF, false));
    else return __builtin_bit_cast(float, __builtin_amdgcn_ds_swizzle(u, (M << 10) | 0x1F));
}
__device__ __forceinline__ float xsum32(float v) { const unsigned u = __builtin_bit_cast(unsigned, v); auto rr = __builtin_amdgcn_permlane32_swap(u, u, false, false);
    return __builtin_bit_cast(float, (unsigned)rr[0]) + __builtin_bit_cast(float, (unsigned)rr[1]); }
__device__ __forceinline__ float xmax32(float v) { const unsigned u = __builtin_bit_cast(unsigned, v); auto rr = __builtin_amdgcn_permlane32_swap(u, u, false, false);
    return fmaxf(__builtin_bit_cast(float, (unsigned)rr[0]), __builtin_bit_cast(float, (unsigned)rr[1])); }
__device__ __forceinline__ float xor32(float v, int hf) { const unsigned u = __builtin_bit_cast(unsigned, v); auto rr = __builtin_amdgcn_permlane32_swap(u, u, false, false);
    return __builtin_bit_cast(float, hf ? (unsigned)rr[0] : (unsigned)rr[1]); }
__device__ __forceinline__ float wave_sum(float v) {
    v += xpart<1>(v); v += xpart<2>(v); v += xpart<4>(v); v += xpart<8>(v); v += xpart<16>(v); v = xsum32(v);
    return v;
}
__device__ __forceinline__ int lane_now() { unsigned ones_ = ~0u; asm volatile("" : "+s"(ones_)); return (int)__builtin_amdgcn_mbcnt_hi(ones_, __builtin_amdgcn_mbcnt_lo(ones_, 0u)); }
__device__ __forceinline__ int ltid(const Args& a) { int t = a.wv * 64 + lane_now(); asm volatile("" : "+v"(t)); return t; }
__device__ __forceinline__ int crow(int r, int hi) { return (r & 3) + 8 * (r >> 2) + 4 * hi; }

__device__ __forceinline__ void row_bt(int row, int& b, int& tok) {
    if (row < NLAT) { b = row >> 11; tok = row & 2047; } else { const int r = row - NLAT; b = r >> 8; tok = SEQ + (r & 255); }
}

__device__ __forceinline__ int na_perm(int j) { return 32 * (j >> 6) + (j & 31) + 128 * ((j >> 5) & 1); }
__device__ __forceinline__ int inproj_row(int n) { return n < 768 ? n : (n < 1024 ? 1024 + na_perm(n - 768) : (n < 1280 ? 1280 + na_perm(n - 1024) : (n < 1536 ? n - 512 : n))); }
__device__ __forceinline__ void transpose_item(const float* W, int N, bf16_t* WT, int ldk, float* scr, int item, int lane, bool remap = false) {
    const int nblk = N / 32, kb = item / nblk, nb = item % nblk, k0 = 64 * kb, n0 = 32 * nb, d0 = remap ? inproj_row(n0) : n0;
    float tv[32];
#pragma unroll
    for (int i = 0; i < 32; ++i) tv[i] = W[(size_t)(k0 + 2 * i + (lane >> 5)) * N + n0 + (lane & 31)];
#pragma unroll
    for (int i = 0; i < 32; ++i) scr[(2 * i + (lane >> 5)) * 33 + (lane & 31)] = tv[i];
    asm volatile("s_waitcnt lgkmcnt(0)" ::: "memory");
    const int c = lane & 7;
#pragma unroll
    for (int j = 0; j < 4; ++j) { const int n = (lane >> 3) + 8 * j; const float* s = scr + (8 * c) * 33 + n;
        u32x4 o; o.x = pk2(s[0 * 33], s[1 * 33]); o.y = pk2(s[2 * 33], s[3 * 33]); o.z = pk2(s[4 * 33], s[5 * 33]); o.w = pk2(s[6 * 33], s[7 * 33]);
        *(u32x4*)(WT + (size_t)(d0 + n) * ldk + k0 + 8 * c) = o; }
    asm volatile("s_waitcnt lgkmcnt(0)" ::: "memory");
}

__device__ __forceinline__ void vecmat9(const Args& a, unsigned char* lds_g, const float* W, int ldw, int ncol_valid, int cb, const float* bias, float* dest, int ldd, int dcb, bool perm = false) {
    const int tid = ltid(a), lane = tid & 63, wave = tid >> 6;
    const float* sl = (const float*)lds_g; float* red = (float*)(lds_g + 9 * 1024 * 4);
    const int n = cb * 256 + 4 * lane; const bool okc = n < ncol_valid;
    f32x4 acc[9];
#pragma unroll
    for (int c = 0; c < 9; ++c) acc[c] = (f32x4){0.f, 0.f, 0.f, 0.f};
    if (okc) { const float* wm = W + n + (size_t)(wave * 128) * ldw;
        f32x4 wc[16], wn[16];
#pragma unroll
        for (int j = 0; j < 16; ++j) wc[j] = *(const f32x4*)(wm + (size_t)j * ldw);
#pragma unroll 1
        for (int kk0 = 0; kk0 < 128; kk0 += 16) {
            const int kn = kk0 + 16 < 128 ? kk0 + 16 : kk0;
#pragma unroll
            for (int j = 0; j < 16; ++j) wn[j] = *(const f32x4*)(wm + (size_t)(kn + j) * ldw);
#pragma unroll
            for (int j = 0; j < 16; ++j) { const int k = wave * 128 + kk0 + j;
#pragma unroll
                for (int c = 0; c < 9; ++c) acc[c] += wc[j] * sl[c * 1024 + k]; }
#pragma unroll
            for (int j = 0; j < 16; ++j) wc[j] = wn[j];
        } }
#pragma unroll
    for (int c = 0; c < 9; ++c) *(f32x4*)(red + (wave * 9 + c) * 256 + 4 * lane) = acc[c];
    __syncthreads();
    for (int i = tid; i < 9 * 256; i += NTHREADS) { const int c = i >> 8, j = i & 255; float s = bias ? bias[cb * 256 + j] : 0.f;
#pragma unroll
        for (int w = 0; w < 8; ++w) s += red[(w * 9 + c) * 256 + j];
        dest[(size_t)c * ldd + dcb * 256 + (perm ? na_perm(j) : j)] = s; }
    __syncthreads();
}

__device__ __forceinline__ void wconv_layer(const Args& a, int layer, int vw, int NV, unsigned char* lds_g) {
    const int lane = ltid(a) & 63, wave = ltid(a) >> 6;
    float* scr = (float*)lds_g + wave * (64 * 33);
    constexpr int IT_IN = 16 * 61, IT_OUT = 16 * 32, IT_F1 = 16 * 128, IT_F2 = 64 * 32, IT_L = IT_IN + IT_OUT + IT_F1 + IT_F2;
    unsigned char* wl = a.ws + WS_W + (size_t)layer * W_LAYER;
    if (vw < 0) return;
    for (int r0 = vw; r0 < IT_L; r0 += NV) { int r = r0;
        if (r < IT_IN) { transpose_item(a.in[I_WIN] + (size_t)layer * 1024 * 1952, 1952, (bf16_t*)(wl + W_IN), 1024, scr, r, lane, true); continue; } r -= IT_IN;
        if (r < IT_OUT) { transpose_item(a.in[I_WOUT] + (size_t)layer * 1024 * 1024, 1024, (bf16_t*)(wl + W_OUT), 1024, scr, r, lane); continue; } r -= IT_OUT;
        if (r < IT_F1) { transpose_item(a.in[I_WFF1] + (size_t)layer * 1024 * 4096, 4096, (bf16_t*)(wl + W_FF1), 1024, scr, r, lane); continue; } r -= IT_F1;
        transpose_item(a.in[I_WFF2] + (size_t)layer * 4096 * 1024, 1024, (bf16_t*)(wl + W_FF2), 4096, scr, r, lane);
    }
}

__device__ __forceinline__ void phase0(const Args& a, unsigned char* lds_g) {
    const int tid = ltid(a), lane = tid & 63, wave = tid >> 6;
    const int gw = blockIdx.x * 8 + wave, NGW = gridDim.x * 8;
    const int gt = blockIdx.x * NTHREADS + tid, NGT = gridDim.x * NTHREADS;
    unsigned char* ws = a.ws;
    {
        float* sl = (float*)lds_g;
        for (int i = tid; i < 9 * 1024; i += NTHREADS) { const int cnd = i >> 10, k = i & 1023; const float v = cnd < 8 ? a.in[I_C][cnd * 1024 + k] : a.in[I_CCTX][k]; sl[i] = v / (1.f + __expf(-v)); }
        __syncthreads();
        for (int it = blockIdx.x; it < DEPTH * 24; it += gridDim.x) {
            const int layer = it / 24, cb = it % 24;
            vecmat9(a, lds_g, a.in[I_WMOD] + (size_t)layer * 1024 * 6144, 6144, 6144, cb, a.in[I_BMOD] + layer * 6144, (float*)(ws + WS_MOD) + (size_t)layer * 9 * 6144, 6144, cb);
        }
        __syncthreads();
    }
    { const int nA = DEPTH * 24 < (int)gridDim.x ? DEPTH * 24 : 0;
        wconv_layer(a, 0, ((int)blockIdx.x - nA) * 8 + wave, ((int)gridDim.x - nA) * 8, lds_g); }
    for (int i = gt; i < DEPTH * 1024 * 256; i += NGT) {
        const int layer = i >> 18, n = (i >> 8) & 1023, k = i & 255; unsigned char* wl = ws + WS_W + (size_t)layer * W_LAYER;
        if (n < 768) ((bf16_t*)(wl + W_Q))[n * 256 + k] = (bf16_t)f2bf(a.in[I_WQUP][((size_t)layer * 256 + k) * 768 + n] * a.in[I_GQA][layer * 256 + k]);
        const int nn = n & 255, hk = ((n & 511) >> 8) * 4 + ((nn >> 5) & 3), dk = 32 * (nn >> 7) + (nn & 31);
        const int hs = (n & 511) >> 6, is = n & 63, srcc = n < 512 ? hk * 128 + dk : hs * 128 + 64 + is;
        float vk = 0.f; if (k < 128) vk = a.in[I_WKVUP][((size_t)layer * 128 + k) * 1024 + srcc] * a.in[I_GKVA][layer * 128 + k];
        ((bf16_t*)(wl + W_KV))[n * 256 + k] = (bf16_t)f2bf(vk);
    }
    for (int i = gt; i < DEPTH * 96 * 1024 / 2; i += NGT) { const int layer = i / (96 * 512), r = i % (96 * 512);
        ((unsigned*)(ws + WS_W + (size_t)layer * W_LAYER + W_IN))[1952 * 512 + r] = 0u; }
    for (int p = gw; p < DEPTH * TOKB; p += NGW) {
        const int layer = p / TOKB, l2 = p % TOKB; const bool isc = l2 >= SEQ; const int L = isc ? CTXL : SEQ, l = isc ? l2 - SEQ : l2;
        const float t = (float)l / (float)(L - 1), w = (6.283185307179586f / (float)L) * (float)l;
        const float* w1 = a.in[I_HW1] + layer * 17 * 64; const float* w2 = a.in[I_HW2] + layer * 64 * 64; const float* fr = a.in[I_HFREQ] + layer * 128;
        float s1 = a.in[I_HB1][layer * 64 + lane] + t * w1[lane];
#pragma unroll
        for (int i = 0; i < 8; ++i) { const float band = 1e-4f + (float)i * ((7.0f - 1e-4f) / 7.0f), ang = band * w;
            s1 += cosf(ang) * w1[(1 + i) * 64 + lane] - sinf(ang) * w1[(9 + i) * 64 + lane]; }
        const float h1 = sinf(fr[lane] * s1);
        float s2 = a.in[I_HB2][layer * 64 + lane];
#pragma unroll
        for (int k = 0; k < 64; ++k) s2 += __builtin_bit_cast(float, __builtin_amdgcn_readlane(__builtin_bit_cast(int, h1), k)) * w2[k * 64 + lane];
        ((float*)(ws + WS_HDN2))[((size_t)layer * TOKB + l2) * 64 + lane] = sinf(fr[64 + lane] * s2);
    }
    for (int i = gt; i < SEQ * 16; i += NGT) { const int s = i >> 4, af = i & 15, ax = af >> 3, f = af & 7;
        const float pos = (float)(ax == 0 ? (s >> 6) : (s & 63)), inv = powf(10000.0f, -(float)f / 8.0f), ang = pos * inv;
        ((float*)(ws + WS_ROPE))[s * 32 + af] = cosf(ang); ((float*)(ws + WS_ROPE))[s * 32 + 16 + af] = sinf(ang); }
}

__device__ __forceinline__ void prenorm_pass(const Args& a, int layer, int which  , int row_lo, int row_hi,
                                             const float* part, int nsplit, const float* pgate, const float* pbias, float* rss, float* rss_zero, const float* xin_lat, const float* xin_ctx, int skipb = 0) {
    const int lane = ltid(a) & 63, wave = ltid(a) >> 6, gw = blockIdx.x * 8 + wave, NGW = gridDim.x * 8;
    const float* g = a.in[which ? I_GN2 : I_GN1] + layer * DM;
    const float* mod = (const float*)(a.ws + WS_MOD) + (size_t)layer * 9 * 6144;
    bf16_t* XN = (bf16_t*)(a.ws + WS_XN);
    float zf = 0.f; asm volatile("" : "+v"(zf)); const f32x4 z4 = {zf, zf, zf, zf};
    for (int i = blockIdx.x * NTHREADS + ltid(a); i < NLAT / 4; i += gridDim.x * NTHREADS) ((f32x4*)rss_zero)[i] = z4;
    if (which == 0) { for (int i = blockIdx.x * NTHREADS + ltid(a); i < NTOK / 4; i += gridDim.x * NTHREADS) { ((f32x4*)(a.ws + WS_CQSS))[i] = z4; ((f32x4*)(a.ws + WS_CKVSS))[i] = z4; }
        }
    if ((int)blockIdx.x >= skipb)
    for (int row = row_lo + gw - skipb * 8; row < row_hi; row += NGW - skipb * 8) {
        float* xr = row < NLAT ? a.out + (size_t)row * DM : (float*)(a.ws + WS_XC) + (size_t)(row - NLAT) * DM;
        const float* xs = row < NLAT ? xin_lat + (size_t)row * DM : xin_ctx + (size_t)(row - NLAT) * DM;
        const int cond = row < NLAT ? (row >> 11) : 8;
        const float* sc = mod + cond * 6144 + (which ? 4 : 1) * 1024;
        const bool pend = nsplit > 0 && row >= NLAT;
        f32x4 v[4]; float ss = 0.f;
#pragma unroll
        for (int j = 0; j < 4; ++j) { v[j] = ((const f32x4*)xs)[64 * j + lane];
            if (pend) { const int c = 4 * (64 * j + lane); f32x4 sm = pbias ? *(const f32x4*)(pbias + c) : (f32x4){0.f, 0.f, 0.f, 0.f};
                for (int sp = 0; sp < nsplit; ++sp) { const u32x2 pq = *(const u32x2*)((const bf16_t*)part + ((size_t)sp * 2048 + (row - NLAT)) * 1024 + c);
                    sm += (f32x4){bflo(pq.x), bfhi(pq.x), bflo(pq.y), bfhi(pq.y)}; }
                v[j] += *(const f32x4*)(pgate + c) * sm; ((f32x4*)xr)[64 * j + lane] = v[j]; }
            ss += (v[j].x * v[j].x + v[j].y * v[j].y) + (v[j].z * v[j].z + v[j].w * v[j].w); }
        ss = wave_sum(ss);
        if (lane == 0) rss[row] = ss;
#pragma unroll
        for (int j = 0; j < 4; ++j) { const int c = 4 * (64 * j + lane);
            const f32x4 gg = *(const f32x4*)(g + c), s1 = *(const f32x4*)(sc + c);
            const f32x4 o = v[j] * gg * (s1 + 1.0f);
            u32x2 w; w.x = pk2(o.x, o.y); w.y = pk2(o.z, o.w);
            *(u32x2*)(XN + (size_t)row * DM + c) = w; }
    }
}
__device__ __forceinline__ void tap_phase(const Args& a, unsigned char* lds_g) {
    const int tid = ltid(a);
    float* hs = (float*)lds_g;
    for (int item = blockIdx.x; item < DEPTH * 64; item += gridDim.x) {
        const int layer = item >> 6, p0 = (item & 63) * 36;
        const float* H = (const float*)(a.ws + WS_HDN2) + ((size_t)layer * TOKB + p0) * 64;
        for (int i = tid; i < 36 * 64 / 4; i += NTHREADS) ((f32x4*)hs)[i] = ((const f32x4*)H)[i];
        const float* w3 = a.in[I_HW3] + (size_t)layer * 64 * 1024 + tid;
        float acc0[36], acc1[36];
        { const float b0 = a.in[I_HB3][layer * 1024 + tid], b1 = a.in[I_HB3][layer * 1024 + 512 + tid];
#pragma unroll
            for (int p = 0; p < 36; ++p) { acc0[p] = b0; acc1[p] = b1; } }
        float wc0[4], wc1[4], wn0[4], wn1[4];
#pragma unroll
        for (int e = 0; e < 4; ++e) { wc0[e] = w3[(size_t)e * 1024]; wc1[e] = w3[(size_t)e * 1024 + 512]; }
        __syncthreads();
#pragma unroll 1
        for (int k4 = 0; k4 < 16; ++k4) {
            const int kn = k4 + 1 < 16 ? k4 + 1 : k4;
#pragma unroll
            for (int e = 0; e < 4; ++e) { wn0[e] = w3[(size_t)(4 * kn + e) * 1024]; wn1[e] = w3[(size_t)(4 * kn + e) * 1024 + 512]; }
#pragma unroll
            for (int p = 0; p < 36; ++p) { const f32x4 h = *(const f32x4*)(hs + p * 64 + 4 * k4);
#pragma unroll
                for (int e = 0; e < 4; ++e) { acc0[p] += h[e] * wc0[e]; acc1[p] += h[e] * wc1[e]; } }
#pragma unroll
            for (int e = 0; e < 4; ++e) { wc0[e] = wn0[e]; wc1[e] = wn1[e]; }
        }
        const float lo = -4.605170185988091f / 1.5f, hi = -4.605170185988091f / 0.3f;
        const float adelta = fabsf(lo + (float)(tid & 255) * ((hi - lo) / 255.0f));
        bf16_t* d0 = (bf16_t*)(a.ws + WS_KTAP) + ((size_t)layer * 1024 + tid) * TOKB + p0; bf16_t* d1 = d0 + (size_t)512 * TOKB;
#pragma unroll
        for (int p = 0; p < 36; p += 4) { unsigned w0[2], w1[2];
#pragma unroll
            for (int q2 = 0; q2 < 2; ++q2) { float v0[2], v1[2];
#pragma unroll
                for (int j = 0; j < 2; ++j) { const int pos = p0 + p + 2 * q2 + j; const bool isc = pos >= SEQ;
                    const float t = isc ? (float)(pos - SEQ) / (float)(CTXL - 1) : (float)pos / (float)(SEQ - 1), dec = expf(-t * adelta);
                    v0[j] = acc0[p + 2 * q2 + j] * dec; v1[j] = acc1[p + 2 * q2 + j] * dec; }
                w0[q2] = pk2(v0[0], v0[1]); w1[q2] = pk2(v1[0], v1[1]); }
            *(u32x2*)(d0 + p) = (u32x2){w0[0], w0[1]}; *(u32x2*)(d1 + p) = (u32x2){w1[0], w1[1]}; }
        __syncthreads();
    }
}
__device__ __forceinline__ void sw_phase(const Args& a, unsigned char* lds_g) {
    float* sl = (float*)lds_g;
    for (int it = blockIdx.x; it < DEPTH * 24; it += gridDim.x) {
        const int layer = it / 24, r = it % 24; const bool ff = r >= 8; const int cb = ff ? r - 8 : r;
        const float* mod = (const float*)(a.ws + WS_MOD) + (size_t)layer * 9 * 6144;
        for (int i = ltid(a); i < 9 * 1024; i += NTHREADS) sl[i] = mod[(i >> 10) * 6144 + (ff ? 3 : 0) * 1024 + (i & 1023)];
        __syncthreads();
        if (ff) vecmat9(a, lds_g, a.in[I_WFF1] + (size_t)layer * 1024 * 4096, 4096, 4096, cb, a.in[I_BFF1] + layer * DFF, (float*)(a.ws + WS_SW2) + (size_t)layer * 9 * 4096, 4096, cb);
        else vecmat9(a, lds_g, a.in[I_WIN] + (size_t)layer * 1024 * 1952, 1952, 1952, cb, nullptr, (float*)(a.ws + WS_SW1) + (size_t)layer * 9 * 2048, 2048, cb < 3 ? cb : (cb == 3 ? 4 : (cb == 4 ? 5 : (cb == 5 ? 3 : cb))), cb == 3 || cb == 4);
    }
    __syncthreads();
}

template <int R, int C>
__device__ __forceinline__ void transpose_tile(const Args& a, const bf16_t* src, size_t ld_s, bf16_t* dst, size_t ld_d, unsigned char* lds_g) {
    static_assert(R % 8 == 0 && C % 8 == 0, "tile");
    constexpr int LDT = C + 2;
    constexpr int NCH = R * C / 8, NI = (NCH + NTHREADS - 1) / NTHREADS;
    unsigned* t32 = (unsigned*)lds_g; const bf16_t* t16 = (const bf16_t*)lds_g;
    const int tid = ltid(a);
#pragma unroll
    for (int i = 0; i < NI; ++i) { const int q = tid + NTHREADS * i, r = q / (C / 8), part = q % (C / 8);
        if (NCH % NTHREADS == 0 || q < NCH) {
        const u32x4 v = *(const u32x4*)(src + (size_t)r * ld_s + part * 8);
        unsigned* d = t32 + (r * LDT + part * 8) / 2; d[0] = v.x; d[1] = v.y; d[2] = v.z; d[3] = v.w; } }
    __syncthreads();
#pragma unroll
    for (int i = 0; i < NI; ++i) { const int p = tid + NTHREADS * i, chunk = p % (R / 8), c = p / (R / 8);
        if (NCH % NTHREADS == 0 || p < NCH) {
        unsigned short e[8];
#pragma unroll
        for (int k = 0; k < 8; ++k) e[k] = t16[(8 * chunk + k) * LDT + c];
        u32x4 o; o.x = e[0] | ((unsigned)e[1] << 16); o.y = e[2] | ((unsigned)e[3] << 16); o.z = e[4] | ((unsigned)e[5] << 16); o.w = e[6] | ((unsigned)e[7] << 16);
        *(u32x4*)(dst + (size_t)c * ld_d + 8 * chunk) = o; } }
    __syncthreads();
}

__device__ __forceinline__ void unpack8(const u32x4 w, float (&x)[8]) {
    x[0] = bflo(w.x); x[1] = bfhi(w.x); x[2] = bflo(w.y); x[3] = bfhi(w.y); x[4] = bflo(w.z); x[5] = bfhi(w.z); x[6] = bflo(w.w); x[7] = bfhi(w.w);
}
__device__ __forceinline__ u32x4 pack8(const float (&x)[8]) { u32x4 o; o.x = pk2(x[0], x[1]); o.y = pk2(x[2], x[3]); o.z = pk2(x[4], x[5]); o.w = pk2(x[6], x[7]); return o; }
__device__ __forceinline__ void mla_unit(const Args& a, int layer, int b, int h, int qb, unsigned char* lds_g) {
    const int tid = ltid(a), lane = tid & 63, wave = __builtin_amdgcn_readfirstlane(tid >> 6), q = lane & 31, hf = lane >> 5;
    unsigned char* A = a.ws + WS_A;
    const bf16_t* QP = (const bf16_t*)(A + A_QP);
    const bf16_t* Kb = (const bf16_t*)(A + A_MK) + (size_t)(b * 8 + h) * TOKB * 96;
    const bf16_t* VTb = (const bf16_t*)(A + A_MVT) + (size_t)(b * 8 + h) * 64 * TOKB;
    bf16_t* MIX = (bf16_t*)(a.ws + WS_A + A_MIX);
    const float* gq = a.in[I_MGQ] + layer * 96;
    const float* ropet = (const float*)(a.ws + WS_ROPE);
    const bool isctx = qb == 8;
    const int t_lo = isctx ? 32 : 0, t_hi = 36;
    const int qpos = qb * 256 + wave * 32 + q;
    const int qrow = isctx ? NLAT + b * CTXL + wave * 32 + q : b * SEQ + qpos;
    constexpr int KSTR = 208, VSTR = 144, KBUF = 64 * KSTR, VBUF = 64 * VSTR;
    constexpr float THR = 6.0f;
    unsigned char* Ks = lds_g; unsigned char* Vs = lds_g + 2 * KBUF;
    u32x4 kA0, kA1, kB0, kB1, vA, vB;
    const int kc0 = tid, kc1 = 512 + (tid & 255);
    const int vd = tid >> 3, vpart = tid & 7;
#define MLA_LOADK(t, S) do { const int tc_ = (t) < t_hi ? (t) : t_hi - 1; const bf16_t* ksrc = Kb + (size_t)tc_ * 64 * 96; k##S##0 = *(const u32x4*)(ksrc + kc0 * 8); k##S##1 = *(const u32x4*)(ksrc + kc1 * 8); } while (0)
#define MLA_LOADV(t, S) do { const int tc_ = (t) < t_hi ? (t) : t_hi - 1; v##S = *(const u32x4*)(VTb + (size_t)vd * TOKB + tc_ * 64 + vpart * 8); } while (0)
#define MLA_STOREK(buf, S) do { *(u32x4*)(Ks + (buf) * KBUF + (kc0 / 12) * KSTR + (kc0 % 12) * 16) = k##S##0; *(u32x4*)(Ks + (buf) * KBUF + (kc1 / 12) * KSTR + (kc1 % 12) * 16) = k##S##1; } while (0)
#define MLA_STOREV(buf, S) do { unsigned char* vd_ = Vs + (buf) * VBUF + vd * VSTR + (vpart >> 1) * 32 + (vpart & 1) * 8; *(u32x2*)vd_ = (u32x2){v##S.x, v##S.y}; *(u32x2*)(vd_ + 16) = (u32x2){v##S.z, v##S.w}; } while (0)
    MLA_LOADK(t_lo, A); MLA_LOADK(t_lo + 1, B);
    const unsigned onew = q == 0 ? 0x3F803F80u : 0u;
    const bf16x8 vones = __builtin_bit_cast(bf16x8, (u32x4){onew, onew, onew, onew});
    bf16x8 qf[6]; float qn2 = 0.f;
    {
        float qv[6][8]; float ss = 0.f;
#pragma unroll
        for (int ks = 0; ks < 6; ++ks) { unpack8(*(const u32x4*)(QP + (size_t)qrow * 768 + h * 96 + 16 * ks + 8 * hf), qv[ks]);
#pragma unroll
            for (int j = 0; j < 8; ++j) ss += qv[ks][j] * qv[ks][j]; }
        ss += xor32(ss, hf);
        const float rs = (0.10206207261596577f * LOG2E) / sqrtf(ss * (1.0f / 96.0f) + EPSF);
#pragma unroll
        for (int ks = 0; ks < 6; ++ks) { const f32x4 g0 = *(const f32x4*)(gq + 16 * ks + 8 * hf), g1 = *(const f32x4*)(gq + 16 * ks + 8 * hf + 4);
#pragma unroll
            for (int j = 0; j < 4; ++j) { qv[ks][j] *= rs * g0[j]; qv[ks][4 + j] *= rs * g1[j]; } }
#pragma unroll
        for (int ks = 4; ks < 6; ++ks) { const float* rp = ropet + (size_t)(isctx ? 0 : qpos) * 32 + (ks - 4) * 8;
            const f32x4 c0 = *(const f32x4*)rp, c1 = *(const f32x4*)(rp + 4), n0_ = *(const f32x4*)(rp + 16), n1_ = *(const f32x4*)(rp + 20);
#pragma unroll
            for (int j = 0; j < 8; ++j) { const float pr = xor32(qv[ks][j], hf);
                if (!isctx) { const float c = j < 4 ? c0[j & 3] : c1[j & 3], sn = j < 4 ? n0_[j & 3] : n1_[j & 3]; qv[ks][j] = hf == 0 ? qv[ks][j] * c - pr * sn : qv[ks][j] * c + pr * sn; } } }
#pragma unroll
        for (int ks = 0; ks < 6; ++ks) qf[ks] = __builtin_bit_cast(bf16x8, pack8(qv[ks]));
#pragma unroll
        for (int ks = 0; ks < 6; ++ks)
#pragma unroll
            for (int j = 0; j < 8; ++j) qn2 += qv[ks][j] * qv[ks][j];
        qn2 += xor32(qn2, hf);
    }
    float gkm = fmaxf(fabsf(a.in[I_MGK][layer * 96 + (lane & 31)]), fmaxf(fabsf(a.in[I_MGK][layer * 96 + 32 + (lane & 31)]), fabsf(a.in[I_MGK][layer * 96 + 64 + (lane & 31)])));
    gkm = fmaxf(gkm, xpart<1>(gkm)); gkm = fmaxf(gkm, xpart<2>(gkm)); gkm = fmaxf(gkm, xpart<4>(gkm)); gkm = fmaxf(gkm, xpart<8>(gkm)); gkm = fmaxf(gkm, xpart<16>(gkm));
    const float mref = sqrtf(qn2) * gkm * (9.797958971132712f * 1.01f);
    f32x16 o0 = {}, o1 = {}, o2 = {};
    f32x16 negm;
#pragma unroll
    for (int r = 0; r < 16; ++r) negm[r] = -mref;
    asm volatile("" : "+v"(negm));
    u32x4 pp[4];
#pragma unroll
    for (int kk = 0; kk < 4; ++kk) pp[kk] = (u32x4){0u, 0u, 0u, 0u};
    MLA_STOREK(t_lo & 1, A); MLA_STOREK((t_lo + 1) & 1, B);
    MLA_LOADK(t_lo + 2, A); MLA_LOADV(t_lo, A);
    for (int i = tid; i < 64 * VSTR / 4; i += NTHREADS) ((unsigned*)(Vs + ((t_lo - 1) & 1) * VBUF))[i] = 0u;
    __syncthreads();
    f32x16 s0 = negm, s1 = negm;
    {   const unsigned char* kb_ = Ks + (t_lo & 1) * KBUF + q * KSTR + (8 * hf) * 2;
#pragma unroll
        for (int ks = 0; ks < 6; ++ks) { s0 = __builtin_amdgcn_mfma_f32_32x32x16_bf16(*(const bf16x8*)(kb_ + 32 * ks), qf[ks], s0, 0, 0, 0);
            s1 = __builtin_amdgcn_mfma_f32_32x32x16_bf16(*(const bf16x8*)(kb_ + 32 * KSTR + 32 * ks), qf[ks], s1, 0, 0, 0); } }
    __syncthreads();
#define NFR 6
#define DPF 5
#define MLA_LD(n_) do { if ((n_) < 8) fr[(n_) % NFR] = *(const bf16x8*)(vb_ + 32 * ((n_) & 1) * VSTR + 32 * ((n_) >> 1)); \
        else if ((n_) < 20) fr[(n_) % NFR] = *(const bf16x8*)(kb_ + 32 * (((n_) - 8) & 1) * KSTR + 32 * (((n_) - 8) >> 1)); } while (0)
#define MLA_CONS(i_) ((i_) < 12 ? ((i_) % 3 < 2 ? 2 * ((i_) / 3) + (i_) % 3 : -1) : (i_) - 4)
#define MLA_SV(e_) ((e_) < 16 ? s0[(e_) & 15] : s1[(e_) & 15])
#define MLA_MFMA(i_) do { const int n_ = MLA_CONS(i_), sl_ = (n_ < 0 ? 0 : n_) % NFR; \
            if ((i_) < 12) { const bf16x8 pf = __builtin_bit_cast(bf16x8, pp[(i_) / 3]); \
                if ((i_) % 3 == 0) o0 = __builtin_amdgcn_mfma_f32_32x32x16_bf16(fr[sl_], pf, o0, 0, 0, 0); \
                else if ((i_) % 3 == 1) o1 = __builtin_amdgcn_mfma_f32_32x32x16_bf16(fr[sl_], pf, o1, 0, 0, 0); \
                else o2 = __builtin_amdgcn_mfma_f32_32x32x16_bf16(vones, pf, o2, 0, 0, 0); } \
            else { const int j_ = (i_) - 12; \
                if (j_ == 0) n0 = __builtin_amdgcn_mfma_f32_32x32x16_bf16(fr[sl_], qf[0], negm, 0, 0, 0); \
                else if (j_ == 1) n1 = __builtin_amdgcn_mfma_f32_32x32x16_bf16(fr[sl_], qf[0], negm, 0, 0, 0); \
                else if ((j_ & 1) == 0) n0 = __builtin_amdgcn_mfma_f32_32x32x16_bf16(fr[sl_], qf[j_ >> 1], n0, 0, 0, 0); \
                else n1 = __builtin_amdgcn_mfma_f32_32x32x16_bf16(fr[sl_], qf[j_ >> 1], n1, 0, 0, 0); \
                if ((PROBE_MASK >> 19) & 1) { dmy = __builtin_amdgcn_mfma_f32_32x32x16_bf16(fr[sl_], qf[j_ >> 1], dmy, 0, 0, 0); } } \
            if (n_ >= 0) MLA_LD(n_ + DPF); } while (0)
#define MLA_ITER(t_, SN, SO) do { \
        MLA_STOREK((t_) & 1, SO); MLA_STOREV((t_) & 1, SO);            \
        MLA_LOADK((t_) + 3, SN); MLA_LOADV((t_) + 1, SN); \
        const unsigned char* vb_ = Vs + (((t_) - 1) & 1) * VBUF + q * VSTR + 16 * hf; \
        const unsigned char* kb_ = Ks + (((t_) + 1) & 1) * KBUF + q * KSTR + (8 * hf) * 2; \
        f32x16 n0, n1; f32x16 dmy = {}; \
          \
        _Pragma("unroll") for (int i = 0; i < 24; ++i) { MLA_MFMA(i); \
            { const int ne = i < 8 ? 2 : 1, e0 = i < 8 ? 2 * i : 8 + i; \
              _Pragma("unroll") for (int e2 = 0; e2 < ne; ++e2) { const int ee = e0 + e2; float pv = __builtin_amdgcn_exp2f(MLA_SV(ee)); asm volatile("" : "+v"(pv));     \
                if (ee < 16) s0[ee & 15] = pv; else s1[ee & 15] = pv; } } \
            { const int w = (i >= 3 && i <= 13) ? i - 3 : ((i >= 15 && (i & 1)) ? (i + 7) / 2 : -1); \
              if (w >= 0) { const int wc_ = w < 0 ? 0 : w; unsigned pw = pk2(MLA_SV(2 * wc_), MLA_SV(2 * wc_ + 1)); asm volatile("" : "+v"(pw)); \
                if ((wc_ & 3) == 0) pp[wc_ >> 2].x = pw; else if ((wc_ & 3) == 1) pp[wc_ >> 2].y = pw; else if ((wc_ & 3) == 2) pp[wc_ >> 2].z = pw; else pp[wc_ >> 2].w = pw; } } \
            __builtin_amdgcn_sched_barrier(0); \
            if (i == 19) { asm volatile("s_barrier" ::: "memory"); __builtin_amdgcn_sched_barrier(0); }     \
        } \
        { const unsigned char* vb_ = Vs + ((t_) & 1) * VBUF + q * VSTR + 16 * hf; MLA_LD(0); MLA_LD(1); MLA_LD(2); MLA_LD(3); MLA_LD(4); }     \
        asm volatile("s_barrier" ::: "memory");                        \
        if ((PROBE_MASK >> 19) & 1) asm volatile("" :: "v"(dmy)); \
        s0 = n0; s1 = n1; } while (0)
    bf16x8 fr[NFR];
    { const unsigned char* vb_ = Vs + ((t_lo - 1) & 1) * VBUF + q * VSTR + 16 * hf; const unsigned char* kb_ = Ks; MLA_LD(0); MLA_LD(1); MLA_LD(2); MLA_LD(3); MLA_LD(4); }
    for (int t = t_lo; t < t_hi; t += 2) { MLA_ITER(t, B, A); MLA_ITER(t + 1, A, B); }
#undef MLA_ITER
#undef MLA_LD
#undef MLA_CONS
#undef MLA_SV
#undef MLA_MFMA
    {
        const unsigned char* vb_ = Vs + ((t_hi - 1) & 1) * VBUF + q * VSTR + 16 * hf;
#pragma unroll
        for (int kk = 0; kk < 4; ++kk) { const bf16x8 pf = __builtin_bit_cast(bf16x8, pp[kk]);
            const bf16x8 v0 = *(const bf16x8*)(vb_ + 32 * kk), v1 = *(const bf16x8*)(vb_ + 32 * VSTR + 32 * kk);
            o0 = __builtin_amdgcn_mfma_f32_32x32x16_bf16(v0, pf, o0, 0, 0, 0); o1 = __builtin_amdgcn_mfma_f32_32x32x16_bf16(v1, pf, o1, 0, 0, 0);
            o2 = __builtin_amdgcn_mfma_f32_32x32x16_bf16(vones, pf, o2, 0, 0, 0); }
    }
    __syncthreads();
#undef MLA_LOADK
#undef MLA_LOADV
#undef MLA_STOREK
#undef MLA_STOREV
    const float l = o2[0] + xor32(o2[0], hf);
    const float il = 1.0f / l;
    bf16_t* dst = MIX + (size_t)qrow * DM + 512 + h * 64;
#pragma unroll
    for (int g4 = 0; g4 < 4; ++g4) {
        u32x2 w0, w1;
        w0.x = pk2(o0[4 * g4] * il, o0[4 * g4 + 1] * il); w0.y = pk2(o0[4 * g4 + 2] * il, o0[4 * g4 + 3] * il);
        w1.x = pk2(o1[4 * g4] * il, o1[4 * g4 + 1] * il); w1.y = pk2(o1[4 * g4 + 2] * il, o1[4 * g4 + 3] * il);
        *(u32x2*)(dst + 8 * g4 + 4 * hf) = w0; *(u32x2*)(dst + 32 + 8 * g4 + 4 * hf) = w1;
    }
}

__device__ __forceinline__ void kfin_phase(const Args& a) {
    const int tid = ltid(a), part = tid & 15, vl = tid >> 4;
    unsigned char* A = a.ws + WS_A;
    const bf16_t* KN = (const bf16_t*)(A + A_KN); const bf16_t* KR = (const bf16_t*)(A + A_KR); bf16_t* MK = (bf16_t*)(A + A_MK);
    const float* knss = (const float*)(a.ws + WS_KNSS); const float* krss = (const float*)(a.ws + WS_KRSS);
    if (part >= 12) return;
    for (int v = blockIdx.x * 32 + vl; v < NTOK * 8; v += gridDim.x * 32) {
        const int row = v >> 3, h = v & 7; int bb, tok; row_bt(row, bb, tok);
        const float rs = __builtin_amdgcn_rsqf((knss[v] + krss[row]) * (1.0f / 96.0f) + EPSF);
        float x[8]; unpack8(part < 8 ? *(const u32x4*)(KN + (size_t)row * 512 + h * 64 + part * 8) : *(const u32x4*)(KR + (size_t)row * 32 + (part - 8) * 8), x);
#pragma unroll
        for (int j = 0; j < 8; ++j) x[j] *= rs;
        *(u32x4*)(MK + ((size_t)(bb * 8 + h) * TOKB + tok) * 96 + part * 8) = pack8(x);
    }
}

__device__ __forceinline__ void na_block(const Args& a, int layer, bool isctx, int u, unsigned char* lds_g) {
    const int tid = ltid(a), lane = tid & 63, wave = __builtin_amdgcn_readfirstlane(tid >> 6), qi = lane & 15, g = lane >> 4;
    int b, h, r0 = 0, half = 0;
    if (isctx) { half = u & 1; h = (u >> 1) & 3; b = u >> 3; } else { r0 = 2 * (u & 15); h = (u >> 4) & 3; b = u >> 6; }
    const int r = r0 + (wave >> 2), j = wave & 3;
    unsigned char* A = a.ws + WS_A;
    const bf16_t* Qb = (const bf16_t*)(A + A_NAQ) + (size_t)(b * 4 + h) * TOKB * 64;
    const bf16_t* Kb = (const bf16_t*)(A + A_NAK) + (size_t)(b * 4 + h) * TOKB * 64;
    const bf16_t* VTb = (const bf16_t*)(A + A_NAVT) + (size_t)(b * 4 + h) * 64 * TOKB;
    bf16_t* MIX = (bf16_t*)(a.ws + WS_A + A_MIX);
    constexpr int KSTR = 144, VSTR = 528, KBUF = 256 * KSTR, VBUF = 64 * VSTR, BUF = KBUF + VBUF;
    static_assert(2 * BUF + 2048 <= LDS_BYTES - 64, "NA LDS");
    float* rpbs = (float*)(lds_g + 2 * BUF);
    if (!isctx) { const float* rpb = a.in[I_RPB] + (size_t)(layer * 4 + h) * 15 * 31; for (int i = tid; i < 465; i += NTHREADS) rpbs[i] = rpb[i] * LOG2E; }
    const int c = 16 * j + qi;
    const int qtok = isctx ? SEQ + half * 128 + wave * 16 + qi : r * 64 + c;
    const int rs = min(max(r - 4, 0), 24), bstart = min(max(16 * j - 8, 0), 32), cs = min(max(c - 8, 0), 48), u0 = min(max(r0 - 4, 0), 24);
    bf16x8 qf[2];
#pragma unroll
    for (int ks = 0; ks < 2; ++ks) qf[ks] = *(const bf16x8*)(Qb + (size_t)qtok * 64 + 32 * ks + 8 * g);
    const int dc0 = bstart + 4 * g - c + 15; unsigned vmask = 0u;
#pragma unroll
    for (int tt = 0; tt < 2; ++tt)
#pragma unroll
        for (int reg = 0; reg < 4; ++reg) { const int kc = bstart + 16 * tt + 4 * g + reg; vmask |= (kc >= cs && kc < cs + 16) ? (1u << (4 * tt + reg)) : 0u; }
    f32x4 o[4];
#pragma unroll
    for (int dt = 0; dt < 4; ++dt) o[dt] = (f32x4){0.f, 0.f, 0.f, 0.f};
    float m = -1e30f, l = 0.f;
    const int nseg = isctx ? 1 : 4;
    u32x4 kr[4][4], vr[4][4];
#define NAB_TOK(sg) ((sg) == 0 ? SEQ : (u0 + 4 * ((sg) - 1)) * 64)
#define NAB_LOAD(sg) do { const int tk = NAB_TOK(sg); _Pragma("unroll") for (int i = 0; i < 4; ++i) { const int ck = tid + NTHREADS * i; \
        kr[sg][i] = *(const u32x4*)(Kb + (size_t)tk * 64 + ck * 8); vr[sg][i] = *(const u32x4*)(VTb + (size_t)(ck >> 5) * TOKB + tk + (ck & 31) * 8); } } while (0)
#define NAB_STORE(bf, sg) do { unsigned char* kd = lds_g + (bf) * BUF; unsigned char* vd = kd + KBUF; _Pragma("unroll") for (int i = 0; i < 4; ++i) { const int ck = tid + NTHREADS * i; \
        *(u32x4*)(kd + (ck >> 3) * KSTR + (ck & 7) * 16) = kr[sg][i]; *(u32x4*)(vd + (ck >> 5) * VSTR + (ck & 31) * 16) = vr[sg][i]; } } while (0)
    NAB_LOAD(0); if (!isctx) { NAB_LOAD(1); NAB_LOAD(2); NAB_LOAD(3); }
    NAB_STORE(0, 0);
    __syncthreads();
#pragma unroll
    for (int sg = 0; sg < 4; ++sg) { if (sg < nseg) {
        const unsigned char* kb_ = lds_g + (sg & 1) * BUF; const unsigned char* vb_ = kb_ + KBUF;
        const int nchk = sg == 0 ? 4 : 2;
#pragma unroll 1
        for (int ch = 0; ch < nchk; ++ch) {
            int lt0, lt1, wi0 = 0, wi1 = 0; bool in0 = true, in1 = true;
            if (sg == 0) { lt0 = 64 * ch; lt1 = lt0 + 32; }
            else { const int R0 = u0 + 4 * (sg - 1) + 2 * ch; wi0 = R0 - rs; wi1 = wi0 + 1; in0 = wi0 >= 0 && wi0 < 8; in1 = wi1 >= 0 && wi1 < 8; lt0 = 128 * ch + bstart; lt1 = lt0 + 64; }
            if (!in0 && !in1) continue;
            f32x4 s[2][2];
#pragma unroll
            for (int g4 = 0; g4 < 2; ++g4) { const int lt = g4 ? lt1 : lt0;
#pragma unroll
                for (int tt = 0; tt < 2; ++tt) { s[g4][tt] = (f32x4){0.f, 0.f, 0.f, 0.f};
#pragma unroll
                    for (int ks = 0; ks < 2; ++ks) { const bf16x8 kf = *(const bf16x8*)(kb_ + (lt + 16 * tt + qi) * KSTR + (32 * ks + 8 * g) * 2);
                        s[g4][tt] = __builtin_amdgcn_mfma_f32_16x16x32_bf16(kf, qf[ks], s[g4][tt], 0, 0, 0); } } }
            if (sg > 0) {
#pragma unroll
                for (int g4 = 0; g4 < 2; ++g4) { const int wi = g4 ? wi1 : wi0; const bool inw = g4 ? in1 : in0; const int dr = min(max(rs + wi - r + 7, 0), 14);
#pragma unroll
                    for (int tt = 0; tt < 2; ++tt)
#pragma unroll
                        for (int reg = 0; reg < 4; ++reg) { const float bias = rpbs[dr * 31 + min(max(dc0 + 16 * tt + reg, 0), 30)]; s[g4][tt][reg] = (inw && ((vmask >> (4 * tt + reg)) & 1u)) ? s[g4][tt][reg] + bias : -1e30f; } }
            }
            float mx = s[0][0][0];
#pragma unroll
            for (int g4 = 0; g4 < 2; ++g4)
#pragma unroll
                for (int tt = 0; tt < 2; ++tt)
#pragma unroll
                    for (int reg = 0; reg < 4; ++reg) mx = fmaxf(mx, s[g4][tt][reg]);
            mx = fmaxf(mx, xpart<16>(mx)); mx = xmax32(mx);
            const float mn = fmaxf(m, mx), alpha = __builtin_amdgcn_exp2f(m - mn);
            float ps = 0.f;
#pragma unroll
            for (int g4 = 0; g4 < 2; ++g4)
#pragma unroll
                for (int tt = 0; tt < 2; ++tt)
#pragma unroll
                    for (int reg = 0; reg < 4; ++reg) { const float pv = __builtin_amdgcn_exp2f(s[g4][tt][reg] - mn); s[g4][tt][reg] = pv; ps += pv; }
            l = l * alpha + ps; m = mn;
#pragma unroll
            for (int dt = 0; dt < 4; ++dt) o[dt] = o[dt] * alpha;
#pragma unroll
            for (int g4 = 0; g4 < 2; ++g4) { const int lt = g4 ? lt1 : lt0;
                u32x4 pw; pw.x = pk2(s[g4][0][0], s[g4][0][1]); pw.y = pk2(s[g4][0][2], s[g4][0][3]); pw.z = pk2(s[g4][1][0], s[g4][1][1]); pw.w = pk2(s[g4][1][2], s[g4][1][3]);
                const bf16x8 pf = __builtin_bit_cast(bf16x8, pw);
#pragma unroll
                for (int dt = 0; dt < 4; ++dt) { const unsigned char* vp = vb_ + (16 * dt + qi) * VSTR + (lt + 4 * g) * 2;
                    const u32x2 lo = *(const u32x2*)vp, hi = *(const u32x2*)(vp + 32);
                    u32x4 w; w.x = lo.x; w.y = lo.y; w.z = hi.x; w.w = hi.y;
                    o[dt] = __builtin_amdgcn_mfma_f32_16x16x32_bf16(__builtin_bit_cast(bf16x8, w), pf, o[dt], 0, 0, 0); }
            }
        }
        if (sg + 1 < nseg) NAB_STORE((sg + 1) & 1, (sg + 1 < 4 ? sg + 1 : 3));
        __syncthreads();
    } }
#undef NAB_TOK
#undef NAB_LOAD
#undef NAB_STORE
    l += xpart<16>(l); l = xsum32(l);
    const float il = 1.0f / l;
    const int orow = isctx ? NLAT + b * CTXL + half * 128 + wave * 16 + qi : b * SEQ + qtok;
    bf16_t* dst = MIX + (size_t)orow * DM + 256 + h * 64 + 4 * g;
#pragma unroll
    for (int dt = 0; dt < 4; ++dt) { u32x2 w; w.x = pk2(o[dt][0] * il, o[dt][1] * il); w.y = pk2(o[dt][2] * il, o[dt][3] * il); *(u32x2*)(dst + 16 * dt) = w; }
}

template <int L>
__device__ __forceinline__ void hyena_unit(const Args& a, int layer, int c, unsigned char* lds_g) {
    constexpr bool ISC = (L == CTXL);
    constexpr int NBLK = L / 32, NTILE = NBLK / 4, GLEN = 2 * L + 256, GST = GLEN + 32, ULEN = L + 200;
    constexpr int OFF_G = 0, OFF_U = OFF_G + 4 * GST * 2, OFF_X1 = OFF_U + 8 * ULEN * 2, OFF_X2 = OFF_X1 + 8 * L * 2, OFF_RED = OFF_X2 + 8 * L * 2, OFF_W3 = OFF_RED + 256;
    static_assert(OFF_W3 + 1024 + 64 <= LDS_BYTES, "hyena LDS");
    const int tid = ltid(a), lane = tid & 63, wave = __builtin_amdgcn_readfirstlane(tid >> 6);
    bf16_t* G = (bf16_t*)(lds_g + OFF_G); bf16_t* U = (bf16_t*)(lds_g + OFF_U); bf16_t* X1 = (bf16_t*)(lds_g + OFF_X1); bf16_t* X2 = (bf16_t*)(lds_g + OFF_X2);
    float* TMP = (float*)(lds_g + OFF_X1);
    float* RED = (float*)(lds_g + OFF_RED);
    static_assert(4 * L * 4 <= 2 * 8 * L * 2, "TMP fits");
    const bf16_t* PT = (const bf16_t*)(a.ws + WS_A + A_PT); bf16_t* OHYT = (bf16_t*)(a.ws + WS_A + A_OHYT);
    const int rowbase = ISC ? NLAT : 0;
    constexpr int NIT = L >= NTHREADS ? L / NTHREADS : 1;
    const bf16_t* ktap = (const bf16_t*)(a.ws + WS_KTAP) + ((size_t)layer * 1024 + c) * TOKB + (ISC ? SEQ : 0);
    unsigned tp[NIT][2];
#pragma unroll
    for (int it = 0; it < NIT; ++it) { const int l = tid + NTHREADS * it; tp[it][0] = 0u; tp[it][1] = 0u;
        if (l < L) { tp[it][0] = (unsigned)ktap[l] | ((unsigned)ktap[(size_t)256 * TOKB + l] << 16); tp[it][1] = (unsigned)ktap[(size_t)512 * TOKB + l] | ((unsigned)ktap[(size_t)768 * TOKB + l] << 16); } }
    u32x4 pw[3][NIT]; unsigned pe[3][NIT];
#define HY_PREF(CH0_, CH1_) _Pragma("unroll") \
    for (int ch = CH0_; ch < CH1_; ++ch) { \
        const bf16_t* src = PT + (size_t)(ch * 256 + c) * NTOK + rowbase; \
        _Pragma("unroll") \
        for (int i = 0; i < NIT; ++i) { \
            const int qd = tid + NTHREADS * i; \
            pw[ch][i] = (u32x4){0u, 0u, 0u, 0u}; pe[ch][i] = 0u; \
            if (qd < L) { const int b = qd / (L / 8), t0 = (qd % (L / 8)) * 8; const bf16_t* sp = src + b * L + t0; \
                pw[ch][i] = *(const u32x4*)sp; \
                const unsigned el = t0 > 0 ? (unsigned)sp[-1] : 0u, er = t0 + 8 < L ? (unsigned)sp[8] : 0u; \
                pe[ch][i] = el | (er << 16); } \
        } \
    }
    HY_PREF(0, 2)
#if 0
    for (int ch = 0; ch < 3; ++ch) {
        const bf16_t* src = PT + (size_t)(ch * 256 + c) * NTOK + rowbase;
#pragma unroll
        for (int i = 0; i < NIT; ++i) {
            const int qd = tid + NTHREADS * i;
            pw[ch][i] = (u32x4){0u, 0u, 0u, 0u}; pe[ch][i] = 0u;
            if (qd < L) { const int b = qd / (L / 8), t0 = (qd % (L / 8)) * 8; const bf16_t* sp = src + b * L + t0;
                pw[ch][i] = *(const u32x4*)sp;
                const unsigned el = t0 > 0 ? (unsigned)sp[-1] : 0u, er = t0 + 8 < L ? (unsigned)sp[8] : 0u;
                pe[ch][i] = el | (er << 16); }
        }
    }
#endif
    {
        float as0 = 0.f, as1 = 0.f;
#pragma unroll
        for (int it = 0; it < NIT; ++it) { const int l = tid + NTHREADS * it;
            if (l < L) { const float k0 = bflo(tp[it][0]), k1 = bfhi(tp[it][0]), k2 = bflo(tp[it][1]), k3 = bfhi(tp[it][1]);
                TMP[0 * L + l] = k0; TMP[1 * L + l] = k1; TMP[2 * L + l] = k2; TMP[3 * L + l] = k3;
                as0 += fabsf(k0) + fabsf(k1); as1 += fabsf(k2) + fabsf(k3); } }
        HY_PREF(2, 3)
#undef HY_PREF
        as0 = wave_sum(as0); as1 = wave_sum(as1);
        if (lane == 0) { RED[wave * 2] = as0; RED[wave * 2 + 1] = as1; }
        __syncthreads();
        float t0 = 0.f, t1 = 0.f;
#pragma unroll
        for (int w = 0; w < 8; ++w) { t0 += RED[w * 2]; t1 += RED[w * 2 + 1]; }
        const float inv0 = 1.0f / (t0 + EPSF), inv1 = 1.0f / (t1 + EPSF);
#pragma unroll 1
        for (int rp = 0; rp < 1 + (ISC ? 0 : ((PROBE_MASK >> 23) & 1)); ++rp)
        for (int i = tid; i < 4 * GST; i += NTHREADS) {
            if (rp) asm volatile("" ::: "memory");
            const int o = i / (2 * GST), cp = (i / GST) & 1, idx = i % GST;
            const int jj = L - (idx - 128 + cp);
            float v = 0.f;
            if (jj >= 0 && jj <= L - 1) v = TMP[(o * 2 + 0) * L + jj]; else if (jj < 0 && -jj <= L - 1) v = TMP[(o * 2 + 1) * L - jj];
            G[i] = (bf16_t)f2bf(v * (o ? inv1 : inv0));
        }
        __syncthreads();
    }
#pragma unroll 1
    for (int rp = 0; rp < 1 + (ISC ? 0 : ((PROBE_MASK >> 24) & 1)); ++rp)
#pragma unroll
    for (int ch = 0; ch < 3; ++ch) {
        if (rp) asm volatile("" ::: "memory");
        const int col = ch * 256 + c;
        const float w0 = a.in[I_HCW][((size_t)layer * 3 + 0) * 768 + col], w1 = a.in[I_HCW][((size_t)layer * 3 + 1) * 768 + col], w2 = a.in[I_HCW][((size_t)layer * 3 + 2) * 768 + col];
        const float cb = a.in[I_HCB][layer * 768 + col];
#pragma unroll
        for (int i = 0; i < NIT; ++i) {
            const int qd = tid + NTHREADS * i;
            if (qd < L) {
                const int b = qd / (L / 8), t0 = (qd % (L / 8)) * 8;
                const u32x4 w = pw[ch][i];
                float u[10];
                u[0] = bflo(pe[ch][i]); u[9] = bfhi(pe[ch][i]);
                u[1] = bflo(w.x); u[2] = bfhi(w.x); u[3] = bflo(w.y); u[4] = bfhi(w.y); u[5] = bflo(w.z); u[6] = bfhi(w.z); u[7] = bflo(w.w); u[8] = bfhi(w.w);
                float y[8];
#pragma unroll
                for (int k = 0; k < 8; ++k) y[k] = w0 * u[k] + w1 * u[k + 1] + w2 * u[k + 2] + cb;
                u32x4 o; o.x = pk2(y[0], y[1]); o.y = pk2(y[2], y[3]); o.z = pk2(y[4], y[5]); o.w = pk2(y[6], y[7]);
                bf16_t* dp = ch == 0 ? U + b * ULEN + 96 + t0 : (ch == 1 ? X1 + b * L + t0 : X2 + b * L + t0);
                *(u32x4*)dp = o;
            }
        }
    }
    for (int i = tid; i < 8 * 96; i += NTHREADS) { const int b = i / 96, k = i % 96; *(unsigned*)(U + b * ULEN + 2 * (k % 48) + (k >= 48 ? 96 + L : 0)) = 0u; }
    __syncthreads();
    const int n = lane & 31, hf = lane >> 5, il = n & 3, bb = n >> 2, ti = n;
    const float hb0 = a.in[I_HBIAS][(layer * 2 + 0) * 256 + c], hb1 = a.in[I_HBIAS][(layer * 2 + 1) * 256 + c];
    const int tau0 = 2 * wave, tau1 = 2 * wave + 1;
    const bool act0 = tau0 < NTILE, act1 = tau1 < NTILE;
#pragma unroll 1
    for (int o = 0; o < 2; ++o) {
        f32x16 acc0 = {}, acc1 = {};
        if constexpr (!ISC) {
            const int dlo = 4 * tau0 - (NBLK - 1);
            const bf16_t* ga = G + (o * 2 + (ti & 1)) * GST + (128 + L - ti + 8 * hf - (ti & 1)) - 32 * dlo;
            const bf16_t* ub = U + bb * ULEN + 96 + 32 * ((NBLK - 1) + il) + 8 * hf;
#define HY_LDA(e_, ks_) ({ const unsigned* gp_ = (const unsigned*)(ga - 32 * (e_) + 16 * (ks_)); u32x4 aw_; aw_.x = gp_[0]; aw_.y = gp_[1]; aw_.z = gp_[2]; aw_.w = gp_[3]; __builtin_bit_cast(bf16x8, aw_); })
#define HY_LDB(e_, ks_) (*(const bf16x8*)(ub - 32 * (e_) + 16 * (ks_)))
            bf16x8 rg[4][2];
#pragma unroll 1
            for (int rp = 0; rp < 1 + ((PROBE_MASK >> 21) & 1); ++rp) {
            if (rp) { float zf = 0.f; asm volatile("" : "+v"(zf)); acc0 *= zf; acc1 *= zf; }
            bf16x8 ca0 = HY_LDA(0, 0), ca1 = HY_LDA(0, 1), cb0 = HY_LDB(0, 0), cb1 = HY_LDB(0, 1);
#define HY_STEP(e_, j_, T0_, T1_, NA_, NB_) { \
                bf16x8 na0 = ca0, na1 = ca1, nb0 = cb0, nb1 = cb1; \
                if (NA_) { na0 = HY_LDA((e_) + 1, 0); na1 = HY_LDA((e_) + 1, 1); } \
                if (NB_) { nb0 = HY_LDB((e_) + 1, 0); nb1 = HY_LDB((e_) + 1, 1); } \
                __builtin_amdgcn_sched_barrier(0); \
                if (T0_) acc0 = __builtin_amdgcn_mfma_f32_32x32x16_bf16(ca0, cb0, acc0, 0, 0, 0); \
                if (T1_) acc1 = __builtin_amdgcn_mfma_f32_32x32x16_bf16(ca0, rg[j_][0], acc1, 0, 0, 0); \
                if (T0_) acc0 = __builtin_amdgcn_mfma_f32_32x32x16_bf16(ca1, cb1, acc0, 0, 0, 0); \
                if (T1_) acc1 = __builtin_amdgcn_mfma_f32_32x32x16_bf16(ca1, rg[j_][1], acc1, 0, 0, 0); \
                if (T0_) { rg[j_][0] = cb0; rg[j_][1] = cb1; } \
                ca0 = na0; ca1 = na1; cb0 = nb0; cb1 = nb1; \
                __builtin_amdgcn_sched_barrier(0); }
#pragma unroll
            for (int j = 0; j < 4; ++j) HY_STEP(j, j, true, false, true, true)
#pragma unroll 1
            for (int g = 1; g < 16; ++g) {
#pragma unroll
                for (int j = 0; j < 4; ++j) HY_STEP(4 * g + j, j, true, true, true, true)
            }
            HY_STEP(64, 0, true, true, true, true)
            HY_STEP(65, 1, true, true, true, true)
            HY_STEP(66, 2, true, true, true, false)
            HY_STEP(67, 3, false, true, true, false)
            HY_STEP(68, 0, false, true, true, false)
            HY_STEP(69, 1, false, true, true, false)
            HY_STEP(70, 2, false, true, false, false)
#undef HY_STEP
            }
#undef HY_LDA
#undef HY_LDB
        } else if (act0) {
            const bf16_t* gb = G + (o * 2 + (ti & 1)) * GST + (128 + L - ti + 8 * hf - (ti & 1));
            const int dlo = 4 * tau0 - (NBLK - 1), dhi = (act1 ? 4 * tau1 : 4 * tau0) + 3;
            for (int d = dlo; d <= dhi; ++d) {
                const bool in0 = d <= 4 * tau0 + 3, in1 = act1 && d >= 4 * tau1 - (NBLK - 1);
#pragma unroll
                for (int ks = 0; ks < 2; ++ks) {
                    const unsigned* gp = (const unsigned*)(gb - 32 * d + 16 * ks);
                    u32x4 aw; aw.x = gp[0]; aw.y = gp[1]; aw.z = gp[2]; aw.w = gp[3];
                    const bf16x8 af = __builtin_bit_cast(bf16x8, aw);
                    if (in0) { const bf16x8 bf = *(const bf16x8*)(U + bb * ULEN + 96 + 32 * (4 * tau0 + il - d) + 16 * ks + 8 * hf);
                        acc0 = __builtin_amdgcn_mfma_f32_32x32x16_bf16(af, bf, acc0, 0, 0, 0); }
                    if (in1) { const bf16x8 bf = *(const bf16x8*)(U + bb * ULEN + 96 + 32 * (4 * tau1 + il - d) + 16 * ks + 8 * hf);
                        acc1 = __builtin_amdgcn_mfma_f32_32x32x16_bf16(af, bf, acc1, 0, 0, 0); }
                }
            }
        }
        const bf16_t* XG = o == 0 ? X1 : X2; const float hb = o == 0 ? hb0 : hb1;
        u32x2 z0[4], z1[4];
#pragma unroll
        for (int g4 = 0; g4 < 4; ++g4) {
            if (act0) { const int t = 32 * (4 * tau0 + il) + 8 * g4 + 4 * hf;
                const u32x2 uw = *(const u32x2*)(U + bb * ULEN + 96 + t), gw = *(const u32x2*)(XG + bb * L + t);
                const float y0 = bflo(gw.x) * (acc0[4 * g4] + hb * bflo(uw.x)), y1 = bfhi(gw.x) * (acc0[4 * g4 + 1] + hb * bfhi(uw.x));
                const float y2 = bflo(gw.y) * (acc0[4 * g4 + 2] + hb * bflo(uw.y)), y3 = bfhi(gw.y) * (acc0[4 * g4 + 3] + hb * bfhi(uw.y));
                z0[g4].x = pk2(y0, y1); z0[g4].y = pk2(y2, y3); }
            if (act1) { const int t = 32 * (4 * tau1 + il) + 8 * g4 + 4 * hf;
                const u32x2 uw = *(const u32x2*)(U + bb * ULEN + 96 + t), gw = *(const u32x2*)(XG + bb * L + t);
                const float y0 = bflo(gw.x) * (acc1[4 * g4] + hb * bflo(uw.x)), y1 = bfhi(gw.x) * (acc1[4 * g4 + 1] + hb * bfhi(uw.x));
                const float y2 = bflo(gw.y) * (acc1[4 * g4 + 2] + hb * bflo(uw.y)), y3 = bfhi(gw.y) * (acc1[4 * g4 + 3] + hb * bfhi(uw.y));
                z1[g4].x = pk2(y0, y1); z1[g4].y = pk2(y2, y3); }
        }
        __syncthreads();
        if (o == 0) {
#pragma unroll
            for (int g4 = 0; g4 < 4; ++g4) {
                if (act0) *(u32x2*)(U + bb * ULEN + 96 + 32 * (4 * tau0 + il) + 8 * g4 + 4 * hf) = z0[g4];
                if (act1) *(u32x2*)(U + bb * ULEN + 96 + 32 * (4 * tau1 + il) + 8 * g4 + 4 * hf) = z1[g4];
            }
            __syncthreads();
        } else {
            bf16_t* dst = OHYT + (size_t)c * NTOK + rowbase + bb * L;
#pragma unroll
            for (int g4 = 0; g4 < 4; ++g4) {
                if (act0) *(u32x2*)(dst + 32 * (4 * tau0 + il) + 8 * g4 + 4 * hf) = z0[g4];
                if (act1) *(u32x2*)(dst + 32 * (4 * tau1 + il) + 8 * g4 + 4 * hf) = z1[g4];
            }
        }
    }
    __syncthreads();
}

__device__ __forceinline__ void mixer_phase(const Args& a, int layer, unsigned char* lds_g) {
    const bool last = layer == DEPTH - 1;
    const int wave = ltid(a) >> 6;
    const int G = gridDim.x, bx = blockIdx.x;
#pragma unroll 1
    for (int rp = 0; rp < 1 + ((PROBE_MASK >> 12) & 1); ++rp)
#pragma unroll 1
    for (int it = bx; it < 256; it += G) hyena_unit<SEQ>(a, layer, it, lds_g);
#pragma unroll 1
    for (int rp = 0; rp < 1 + ((PROBE_MASK >> 13) & 1); ++rp)
#pragma unroll 1
    for (int it = bx; it < (last ? 512 : 576); it += G) {
        if (it < 512) { int bh = it >> 3, qb = it & 7;
            if (G == 256) { const int rr = it >> 8, x = bx & 7, sl = bx >> 3; bh = 32 * rr + (sl >> 3) * 8 + x; qb = sl & 7; }
            mla_unit(a, layer, bh >> 3, bh & 7, qb, lds_g); }
        else { const int u = it - 512; mla_unit(a, layer, u >> 3, u & 7, 8, lds_g); } }
#pragma unroll 1
    for (int rp = 0; rp < 1 + ((PROBE_MASK >> 14) & 1); ++rp)
#pragma unroll 1
    for (int it = bx; it < (last ? 512 : 576); it += G) {
        if (it < 512) { int u = it;
            if (G == 256) { const int rr = it >> 8, x = bx & 7, sl = bx >> 3; u = (16 * rr + (sl >> 4) * 8 + x) * 16 + (sl & 15); }
            na_block(a, layer, false, u, lds_g); }
        else if (G != 256) na_block(a, layer, true, it - 512, lds_g); }
    if (G == 256 && !last && bx >= 64 && bx < 128) {
#pragma unroll 1
        for (int rp = 0; rp < 1 + ((PROBE_MASK >> 14) & 1); ++rp) na_block(a, layer, true, bx - 64, lds_g); }
    if (!last) {
#pragma unroll 1
    for (int rp = 0; rp < 1 + ((PROBE_MASK >> 15) & 1); ++rp)
#pragma unroll 1
        for (int it = bx; it < 256; it += G) hyena_unit<CTXL>(a, layer, it, lds_g);
    }
}
__device__ __forceinline__ void ohy_phase(const Args& a, int nrows, unsigned char* lds_g) {
    const bf16_t* OHYT = (const bf16_t*)(a.ws + WS_A + A_OHYT); bf16_t* MIX = (bf16_t*)(a.ws + WS_A + A_MIX);
    if (nrows == NTOK) {
        for (int item = blockIdx.x; item < NTOK / 72; item += gridDim.x)
            transpose_tile<256, 72>(a, OHYT + item * 72, NTOK, MIX + (size_t)item * 72 * DM, DM, lds_g);
    } else
    for (int item = blockIdx.x; item < nrows / 64; item += gridDim.x)
        transpose_tile<256, 64>(a, OHYT + item * 64, NTOK, MIX + (size_t)item * 64 * DM, DM, lds_g);
}


#define GAS __attribute__((address_space(1)))
typedef GAS unsigned gu32;
#define XB_TMO      128
#define XB_XCNT(j)  (256  + 64 * (j))
#define XB_XSUB(j)  (1280 + 64 * (j))
#define XB_XGEN(j)  (2304 + 64 * (j))
#define XB_TOP      3328
#define XB_TOPGEN   3392
#define XCD_BAR_WORDS 3456
#define XB_SPIN_CAP (1u << 18)

__device__ __forceinline__ unsigned xb_ld(unsigned* p)              { return __hip_atomic_load(p, __ATOMIC_RELAXED, __HIP_MEMORY_SCOPE_AGENT); }
__device__ __forceinline__ unsigned xb_add(unsigned* p, unsigned v) { return __hip_atomic_fetch_add(p, v, __ATOMIC_RELAXED, __HIP_MEMORY_SCOPE_AGENT); }
__device__ __forceinline__ unsigned xb_xcc_id() { return (unsigned)__builtin_amdgcn_s_getreg((3 << 11) | 20) & 0xFu; }
#define XB_SPIN(cond, bar) do { unsigned _sp = 0; while (cond) { __builtin_amdgcn_s_sleep(1); \
    if ((++_sp & 255u) == 0u) { if (xb_ld(&(bar)[XB_TMO])) break; if (_sp > XB_SPIN_CAP) { atomicAdd(&(bar)[XB_TMO], 1u); break; } } } } while (0)

struct XcdBarrier {
    unsigned* bar; unsigned x;
    volatile LAS unsigned* st;
};

__device__ __forceinline__ XcdBarrier xcd_barrier_post(unsigned* bar, volatile LAS unsigned* st, bool leader) {
    XcdBarrier b; b.bar = bar; b.x = xb_xcc_id(); b.st = st;
    if (leader) (void)xb_add(&bar[XB_XCNT(b.x)], 1u);
    return b;
}
__device__ __forceinline__ void xcd_barrier_complete(unsigned* bar, unsigned x, unsigned& nloc, unsigned& nx) {
    const unsigned G = gridDim.x * gridDim.y * gridDim.z;
    unsigned sum, cnt, mine, sp = 0u;
    for (;;) {
        sum = 0u; cnt = 0u; mine = 0u;
#pragma unroll
        for (unsigned j = 0; j < 16; ++j) { const unsigned c = xb_ld(&bar[XB_XCNT(j)]); sum += c; cnt += (c > 0u) ? 1u : 0u; mine = (j == x) ? c : mine; }
        if (sum == G) break;
        __builtin_amdgcn_s_sleep(1);
        if ((++sp & 255u) == 0u) { if (xb_ld(&bar[XB_TMO])) break; if (sp > XB_SPIN_CAP) { atomicAdd(&bar[XB_TMO], 1u); break; } }
    }
    nloc = mine > 0u ? mine : 1u; nx = cnt > 0u ? cnt : 1u;
}

__device__ __forceinline__ void xcd_barrier(const XcdBarrier& b, bool leader) {
    asm volatile("s_waitcnt vmcnt(0)" ::: "memory");
    __syncthreads();
    if (leader) {
        unsigned* bar = b.bar;
        __builtin_amdgcn_s_waitcnt(0);
        unsigned nloc = b.st[0], nx = b.st[1];
        if (nloc == 0u) { xcd_barrier_complete(bar, b.x, nloc, nx); b.st[0] = nloc; b.st[1] = nx; }
        const unsigned old = xb_add(&bar[XB_XSUB(b.x)], 1u);
        const unsigned gen = old / nloc;
        if (old + 1u == (gen + 1u) * nloc) {
            __builtin_amdgcn_fence(__ATOMIC_RELEASE, "agent");
            asm volatile("s_waitcnt vmcnt(0)" ::: "memory");
            const unsigned og = xb_add(&bar[XB_TOP], 1u);
            const unsigned tg = og / nx;
            if (og + 1u == (tg + 1u) * nx) xb_add(&bar[XB_TOPGEN], 1u);
            else XB_SPIN(xb_ld(&bar[XB_TOPGEN]) == tg, bar);
            __builtin_amdgcn_fence(__ATOMIC_ACQUIRE, "agent");
            xb_add(&bar[XB_XGEN(b.x)], 1u);
            asm volatile("s_waitcnt vmcnt(0)" ::: "memory");
        } else {
            XB_SPIN(xb_ld(&bar[XB_XGEN(b.x)]) == gen, bar);
            __builtin_amdgcn_fence(__ATOMIC_ACQUIRE, "agent");
            asm volatile("s_waitcnt vmcnt(0)" ::: "memory");
        }
    }
    __syncthreads();
}

constexpr int PH_PER_LAYER = 9, N_PHASES = 1 + DEPTH * PH_PER_LAYER;
template <bool SYNC>
__global__ void __launch_bounds__(NTHREADS, 2) fwd_kernel(Args a_) {
    extern __shared__ __attribute__((aligned(16))) unsigned char lds[];
    unsigned char* lds_g = lds;
    LAS unsigned char* lds3 = (LAS unsigned char*)lds;
    volatile LAS unsigned* bst = (volatile LAS unsigned*)(lds3 + LDS_BYTES - 64);
    XcdBarrier bar; bar.bar = nullptr; bar.x = 0; bar.st = nullptr;
    const int wv0 = __builtin_amdgcn_readfirstlane((int)(threadIdx.x >> 6));
#define LEADER_ (wv0 == 0 && lane_now() == 0)
    if (SYNC) { if (wv0 == 0 && lane_now() < 2) bst[lane_now()] = 0u; __syncthreads(); bar = xcd_barrier_post((unsigned*)a_.ws + 4096, bst, LEADER_); }
    for (int ph = a_.ph_lo; ph < a_.ph_hi; ++ph) {
      for (int rep = 0; rep < 2; ++rep) {
        if (rep == 1) { const int kq = (ph - 1) % PH_PER_LAYER, kk = ph == 0 ? 11 : (kq < 2 ? kq : (kq == 2 ? 3 : kq + 2)); if (!((PROBE_MASK >> kk) & 1)) break; __syncthreads(); if (SYNC) xcd_barrier(bar, LEADER_); }
        Args a = a_; a.wv = wv0;
        { size_t z = 0; asm volatile("" : "+s"(z)); a.ws = a_.ws + z; a.out = a_.out + z; }
        unsigned char* ws = a.ws;
        if (ph == 0) phase0(a, lds_g);
        else {
            const int layer = (ph - 1) / PH_PER_LAYER, kq = (ph - 1) % PH_PER_LAYER, k = kq < 2 ? kq : (kq == 2 ? 3 : kq + 2);
            const bool last = layer == DEPTH - 1;
            const int Mres = last ? NLAT : NTOK;
            unsigned char* wl = ws + WS_W + (size_t)layer * W_LAYER;
            unsigned char* A = ws + WS_A;
            const float* mod = (const float*)(ws + WS_MOD) + (size_t)layer * 9 * 6144;
            float* RSS1 = (float*)(ws + WS_RSS1); float* RSS2 = (float*)(ws + WS_RSS2);
            const unsigned oW = (unsigned)(WS_W + (size_t)layer * W_LAYER), oMOD = (unsigned)(WS_MOD + (size_t)layer * 9 * 6144 * 4), oA = (unsigned)WS_A;
            pg8::EpiX E; E.ws = ws; E.mode = 0; E.bias = nullptr; E.xlat = a.out; E.xdx = 0; E.o_gate = 0; E.o_part = 0; E.o_sw = 0; E.ldsw = 0; E.xgf = 0; E.gn = nullptr; E.o_gsc = 0; E.o_rssout = 0;
            E.o_cqss = (unsigned)WS_CQSS; E.o_ckvss = (unsigned)WS_CKVSS; E.gk = a.in[I_MGK] + layer * 96; E.knf = 0; E.nagq = a.in[I_NAGQ] + layer * 64; E.nagk = a.in[I_NAGK] + layer * 64;
            pg8::Sub sn; sn.A = 0; sn.Bt = 0; sn.M = 0; sn.N = 256; sn.kind = 0; sn.O = 0; sn.ldc = 0; sn.rss = 0; sn.rdiv = 0.f;
            pg8::Sub s0 = sn, s1 = sn, s2 = sn; int nsub = 0, Kdim = 0, ksplit = 1;
            switch (k) {
            case 0: if (layer == 0) { if (rep == 0) { tap_phase(a, lds_g); sw_phase(a, lds_g); } prenorm_pass(a, 0, 0, 0, NTOK, nullptr, 0, nullptr, nullptr, RSS1, RSS2, a.in[I_X], a.in[I_CTX], (rep == 0 && DEPTH * 24 < (int)gridDim.x) ? DEPTH * 24 : 0); }
                    else prenorm_pass(a, layer, 0, NLAT, NTOK, (const float*)(A + A_PART10), rep == 0 ? 8 : 0, mod - 9 * 6144 + 8 * 6144 + 5 * 1024, a.in[I_BFF2] + (layer - 1) * DM, RSS1, RSS2, a.out, (const float*)(ws + WS_XC));
                    break;
            case 1:
                    s0.A = oW + (unsigned)W_IN; s0.Bt = (unsigned)WS_XN; s0.M = 1024; s0.N = NTOK; s0.kind = 1;
                    s1.A = (unsigned)WS_XN; s1.Bt = oW + (unsigned)W_IN + 1024u * DM * 2u; s1.M = NTOK; s1.N = 1024; s1.kind = 2;
                    nsub = 2; Kdim = DM; E.o_sw = (unsigned)(WS_SW1 + (size_t)layer * 9 * 2048 * 4); E.ldsw = 2048;
                    if (rep) { E.o_cqss = (unsigned)WS_RSSDUMMY; E.o_ckvss = (unsigned)WS_RSSDUMMY; }
                    break;
            case 3:
                    s0.A = oA + (unsigned)A_CQ; s0.Bt = oW + (unsigned)W_Q; s0.M = NTOK; s0.N = 768; s0.O = oA + (unsigned)A_QP; s0.ldc = 768; s0.rss = (unsigned)WS_CQSS; s0.rdiv = 1.0f / 256.0f;
                    s1.A = oA + (unsigned)A_CKV; s1.Bt = oW + (unsigned)W_KV; s1.M = NTOK; s1.N = 512; s1.O = oA + (unsigned)A_KN; s1.ldc = 512; s1.rss = (unsigned)WS_CKVSS; s1.rdiv = 1.0f / 128.0f;
                    s2.A = oW + (unsigned)W_KV + 512u * 256u * 2u; s2.Bt = oA + (unsigned)A_CKV; s2.M = 512; s2.N = NTOK; s2.kind = 3;
                    nsub = 3; Kdim = 256; E.knf = 1; break;
            case 5: mixer_phase(a, layer, lds_g); break;
            case 6: ohy_phase(a, Mres, lds_g); break;
            case 7: if (layer == 0 && rep == 0) E.xdx = (long long)((const char*)a.in[I_X] - (const char*)a.out);
                    s0.A = oA + (unsigned)A_MIX; s0.Bt = oW + (unsigned)W_OUT; s0.M = Mres; s0.N = DM; nsub = 1; Kdim = DM; E.mode = 2; ksplit = 4; E.o_part = oA + (unsigned)A_PART7;
                    E.xgf = 1; E.gn = a.in[I_GN2] + layer * DM; E.o_gsc = oMOD + 4 * 1024 * 4; E.o_rssout = rep ? (unsigned)WS_RSSDUMMY : (unsigned)WS_RSS2;
                    E.o_gate = rep ? 256u * 1024u : oMOD + 2 * 1024 * 4; break;
            case 8: if (!last) prenorm_pass(a, layer, 1, NLAT, NTOK, (const float*)(A + A_PART7), rep == 0 ? 4 : 0, mod + 8 * 6144 + 2 * 1024, nullptr, RSS2, RSS1, a.out, layer == 0 ? a.in[I_CTX] : (const float*)(ws + WS_XC)); break;
            case 9: s0.A = (unsigned)WS_XN; s0.Bt = oW + (unsigned)W_FF1; s0.M = Mres; s0.N = DFF; s0.O = oA + (unsigned)A_H; s0.ldc = DFF; s0.rss = (unsigned)WS_RSS2; s0.rdiv = 1.0f / 1024.0f; nsub = 1; Kdim = DM; E.mode = 1;
                    E.o_sw = (unsigned)(WS_SW2 + (size_t)layer * 9 * 4096 * 4); E.ldsw = 4096; break;
            case 10: s0.A = oA + (unsigned)A_H; s0.Bt = oW + (unsigned)W_FF2; s0.M = Mres; s0.N = DM; nsub = 1; Kdim = DFF; E.mode = 2; ksplit = 8; E.o_part = oA + (unsigned)A_PART10;
                    E.o_gate = rep ? 256u * 1024u : oMOD + 5 * 1024 * 4; E.bias = a.in[I_BFF2] + layer * DM;
                    if (!last) { E.xgf = 1; E.gn = a.in[I_GN1] + (layer + 1) * DM; E.o_gsc = oMOD + (9 * 6144 + 1 * 1024) * 4; E.o_rssout = rep ? (unsigned)WS_RSSDUMMY : (unsigned)WS_RSS1; } break;
            }
            if (nsub > 0) {
                E.oO0 = s0.O; E.ldc0 = s0.ldc; E.orss0 = s0.rss; E.rdiv0 = s0.rdiv; E.oO1 = s1.O; E.ldc1 = s1.ldc; E.orss1 = s1.rss; E.rdiv1 = s1.rdiv;
                E.oO2 = s2.O; E.ldc2 = s2.ldc; E.orss2 = s2.rss; E.rdiv2 = s2.rdiv;
                pg8::Order S; S.init((const char*)ws, s0, s1, s2, nsub, Kdim, ksplit, gridDim.x, blockIdx.x);
                pg8::Gemm g{nullptr, nullptr, a.wv, 0, Kdim};
                pg8::gemm_phase<pg8::EpiX, pg8::Order, true, true>(lds3, g, S, E);
                if (k == 9 && rep == 0 && !last) {
                    const int nu = (Mres / 256) * 16, rem = nu % (int)gridDim.x;
                    wconv_layer(a, layer + 1, ((int)blockIdx.x - rem) * 8 + (int)(ltid(a) >> 6), ((int)gridDim.x - rem) * 8, lds_g);
                }
            }
        }
      }
        if (SYNC && ph + 1 < a_.ph_hi) { if (a_.ph_hi < 0) cg::this_grid().sync(); else xcd_barrier(bar, LEADER_); }
        else __syncthreads();
    }
}

extern "C" void kernel_launch(void* const* d_in, const int* in_sizes, int n_in, void* d_out, int out_size, void* d_ws, size_t ws_size, hipStream_t stream) {
    static int grid = 0;
    if (grid == 0) {
        if (n_in != 33 || out_size != NLAT * DM || ws_size < WS_END) { fprintf(stderr, "kernel_launch: unexpected shapes (n_in %d out %d ws %zu)\n", n_in, out_size, ws_size); grid = -1; return; }
        int dev = 0, cus = 0, per_cu = 0;
        (void)hipGetDevice(&dev); (void)hipDeviceGetAttribute(&cus, hipDeviceAttributeMultiprocessorCount, dev);
        (void)hipFuncSetAttribute((const void*)fwd_kernel<true>, hipFuncAttributeMaxDynamicSharedMemorySize, LDS_BYTES);
        if (hipOccupancyMaxActiveBlocksPerMultiprocessor(&per_cu, (const void*)fwd_kernel<true>, NTHREADS, LDS_BYTES) != hipSuccess || per_cu < 1) { fprintf(stderr, "kernel_launch: occupancy query says %d blocks per CU\n", per_cu); per_cu = 1; }
        (void)hipGetLastError();
        grid = (cus > 0 ? cus : 256);
    }
    if (grid < 0) return;
    Args a{};
    for (int i = 0; i < 33; ++i) a.in[i] = (const float*)d_in[i];
    a.out = (float*)d_out; a.ws = (unsigned char*)d_ws;
    a.ph_lo = 0; a.ph_hi = N_PHASES;
    if (hipMemsetAsync(d_ws, 0, 512 * 1024, stream) != hipSuccess) { fprintf(stderr, "kernel_launch: memset failed\n"); return; }
    void* args[] = {&a};
    hipError_t e = hipLaunchCooperativeKernel((const void*)fwd_kernel<true>, dim3(grid), dim3(NTHREADS), args, LDS_BYTES, stream);
    if (e != hipSuccess) fprintf(stderr, "cooperative launch failed: %s (grid %d)\n", hipGetErrorString(e), grid);
}
```

```cpp
#include <hip/hip_runtime.h>
#include <hip/hip_cooperative_groups.h>
#include <cstdio>
#include <cstdint>
namespace cg = cooperative_groups;
#ifndef PROBE_MASK
#define PROBE_MASK 0
#endif
#define LAS __attribute__((address_space(3)))
typedef unsigned short bf16_t;
typedef short bf16x8 __attribute__((ext_vector_type(8)));
typedef float f32x4 __attribute__((ext_vector_type(4)));
typedef float f32x16 __attribute__((ext_vector_type(16)));
typedef unsigned u32x4 __attribute__((ext_vector_type(4)));
typedef unsigned u32x2 __attribute__((ext_vector_type(2)));

constexpr int DM = 1024, NB = 8, SEQ = 2048, DEPTH = 4, CTXL = 256, TOKB = SEQ + CTXL  ;
constexpr int NLAT = NB * SEQ  , NCTX = NB * CTXL  , NTOK = NLAT + NCTX  ;
constexpr int INP = 2048;
constexpr int DFF = 4096;
constexpr float EPSF = 1e-6f;
constexpr float LOG2E = 1.4426950408889634f;
constexpr int NTHREADS = 512;
constexpr int LDS_BYTES = 152 * 1024;

constexpr size_t MiB = (size_t)1 << 20;
constexpr size_t WS_MOD = 1 * MiB, WS_HDN2 = 2 * MiB, WS_ROPE = 5 * MiB, WS_W = 6 * MiB, W_LAYER = 23 * MiB;
constexpr size_t W_IN = 0, W_Q = 4 * MiB, W_KV = 4 * MiB + MiB / 2, W_OUT = 5 * MiB, W_FF1 = 7 * MiB, W_FF2 = 15 * MiB;
constexpr size_t WS_XC = 98 * MiB, WS_XN = 106 * MiB, WS_A = 142 * MiB;
constexpr size_t A_QP = 0, A_KN = 36 * MiB, A_PT = 72 * MiB, A_NAQ = 99 * MiB, A_NAK = 108 * MiB, A_NAVT = 117 * MiB;
constexpr size_t A_MIX = 146 * MiB, A_PART7 = 0, A_PART10 = 146 * MiB;
constexpr size_t WS_RSS1 = 512 * 1024, WS_RSS2 = 592 * 1024, WS_SW1 = 704 * 1024, WS_RSSDUMMY = 5 * 1024 * 1024 + 840 * 1024;
constexpr size_t A_CQ = 126 * MiB, A_OHYT = 126 * MiB, A_CKV = 135 * MiB, A_KR = 144 * MiB, A_MVT = 54 * MiB, A_MK = 182 * MiB, A_H = 0;
constexpr size_t WS_CQSS = WS_HDN2 + 2400 * 1024, WS_CKVSS = WS_HDN2 + 2480 * 1024;
constexpr size_t WS_KRSS = WS_HDN2 + 2560 * 1024;
constexpr size_t WS_KNSS = 360 * MiB;
constexpr size_t WS_SW2 = WS_ROPE + 256 * 1024;
constexpr size_t A_HYGL = 36 * MiB, A_HYGC = 46 * MiB;
constexpr size_t WS_KTAP = 352 * MiB;
constexpr size_t WS_END = 371 * MiB;

struct Args { const float* in[33]; float* out; unsigned char* ws; int ph_lo, ph_hi; int wv; };
enum { I_X = 0, I_C, I_CTX, I_CCTX, I_WMOD, I_BMOD, I_GN1, I_WIN, I_HCW, I_HCB, I_HW1, I_HB1, I_HW2, I_HB2, I_HW3, I_HB3, I_HFREQ, I_HBIAS,
       I_NAGQ, I_NAGK, I_RPB, I_GQA, I_GKVA, I_WQUP, I_WKVUP, I_MGQ, I_MGK, I_WOUT, I_GN2, I_WFF1, I_BFF1, I_WFF2, I_BFF2 };

namespace pg8 {
#define PG8_LAS __attribute__((address_space(3)))
typedef unsigned short bf16_t;
typedef short bf16x8 __attribute__((ext_vector_type(8)));
typedef float f32x4 __attribute__((ext_vector_type(4)));
typedef unsigned u32x4 __attribute__((ext_vector_type(4)));
constexpr int BM = 256, BK = 64, HALF = 128, HTB = HALF * BK * 2  , STAGE_BYTES = 8 * HTB, NXCD = 8, WGM = 8;

__host__ __device__ __forceinline__ int lds_byte(int r, int c) { const int st = (r >> 4) * 2 + (c >> 5), rr = r & 15, cc = c & 31, ob = rr * 64 + cc * 2; return st * 1024 + (ob ^ (((ob >> 9) & 1) << 5)); }
__host__ __device__ __forceinline__ void stage_rc(int b, int& R, int& C) { const int st = b / 1024, sb = b % 1024, swz = sb ^ (((sb >> 9) & 1) << 5); R = (st >> 1) * 16 + swz / 64; C = (st & 1) * 32 + (swz % 64) / 2; }
__host__ __device__ __forceinline__ int perm32(int rho) { const int n = rho >> 4, i = rho & 15; return 8 * (i >> 2) + 4 * n + (i & 3); }

struct Unit { const char* A; const char* B; int pm, pn, nt, sp, at, sub, kind; };
struct Gemm { const bf16_t* A; const bf16_t* Bt; int M, N, K; };

struct StaticOrder {
    int nM, nN, nwg, G, c;
    __host__ __device__ void init(int M, int N, int G_, int c_) { nM = M / BM; nN = N / BM; nwg = nM * nN; G = G_; c = c_; }
    __host__ __device__ bool next(int i, Unit& u) const {
        const long L = (long)i * G + c; if (L >= nwg) return false;
        int wgid = (int)L; { const int q = nwg / NXCD, r = nwg % NXCD, xcd = wgid % NXCD, off = wgid / NXCD; wgid = (xcd < r ? xcd * (q + 1) : r * (q + 1) + (xcd - r) * q) + off; }
        const int nig = WGM * nN, gid = wgid / nig, fm = gid * WGM, gsz = (nM - fm) < WGM ? (nM - fm) : WGM;
        u.pm = fm + ((wgid % nig) % gsz); u.pn = (wgid % nig) / gsz; return true;
    }
    __device__ __forceinline__ void a_ready(const Unit&) const {}
    __device__ __forceinline__ void done(const Unit&) const {}
};

__device__ __forceinline__ unsigned cvt_pk_bf16(float lo, float hi) { unsigned r; asm volatile("v_cvt_pk_bf16_f32 %0, %1, %2" : "=v"(r) : "v"(lo), "v"(hi)); return r; }
constexpr int NTOK_ = 18432, TOKB_ = 2304;
struct Sub { unsigned A, Bt; int M, N, kind; unsigned O; int ldc; unsigned rss; float rdiv; };
#if (PROBE_MASK >> 16) & 1
#define EPI_ATOMIC(p_, v_) do { const float hv_ = 0.5f * (v_); (void)__hip_atomic_fetch_add((p_), hv_, __ATOMIC_RELAXED, __HIP_MEMORY_SCOPE_AGENT); (void)__hip_atomic_fetch_add((p_), hv_, __ATOMIC_RELAXED, __HIP_MEMORY_SCOPE_AGENT); } while (0)
#else
#define EPI_ATOMIC(p_, v_) (void)__hip_atomic_fetch_add((p_), (v_), __ATOMIC_RELAXED, __HIP_MEMORY_SCOPE_AGENT)
#endif
struct EpiX {
    static constexpr bool PERM = true, AFTER_DRAIN = false;
    int mode;
    unsigned char* ws;
    unsigned oO0, oO1, oO2; int ldc0, ldc1, ldc2; unsigned orss0, orss1, orss2; float rdiv0, rdiv1, rdiv2;
    const float* bias;
    float* xlat;
    long long xdx;
    unsigned o_gate;
    unsigned o_sw; int ldsw;
    int xgf; const float* gn; unsigned o_gsc, o_rssout;
    unsigned o_part;
    unsigned o_cqss, o_ckvss;
    const float* gk;
    const float* nagq; const float* nagk;
    int knf;
    __device__ __forceinline__ void operator()(const f32x4 (&acc)[2][2][4][2], const Unit& u, int wr, int wc, int fr_in, int fq_in) const {
        (void)fr_in; (void)fq_in;
        unsigned ones_ = ~0u; asm volatile("" : "+s"(ones_));
        int lane_ = (int)__builtin_amdgcn_mbcnt_hi(ones_, __builtin_amdgcn_mbcnt_lo(ones_, 0u)); asm volatile("" : "+v"(lane_));
        const int fr = lane_ & 15, fq = lane_ >> 4;
#define EPI_SHX(v_, m_) __builtin_bit_cast(float, __builtin_amdgcn_ds_bpermute((lane_ ^ (m_)) << 2, __builtin_bit_cast(int, (float)(v_))))
        const int row0 = u.pm * BM + wr * 64 + fr;
        const int col0 = u.pn * BM + wc * 32 + 8 * fq;
        unsigned char* Ab = ws + WS_A;
        bf16_t* PT = (bf16_t*)(Ab + A_PT); bf16_t* NAVT = (bf16_t*)(Ab + A_NAVT); bf16_t* NAQ = (bf16_t*)(Ab + A_NAQ); bf16_t* NAK = (bf16_t*)(Ab + A_NAK); bf16_t* CQ = (bf16_t*)(Ab + A_CQ);
        bf16_t* CKV = (bf16_t*)(Ab + A_CKV); bf16_t* KR = (bf16_t*)(Ab + A_KR); bf16_t* MVT = (bf16_t*)(Ab + A_MVT);
        float* cqss = (float*)(ws + o_cqss); float* ckvss = (float*)(ws + o_ckvss); const float* rss1 = (const float*)(ws + WS_RSS1);
        const float* sw = (const float*)(ws + o_sw); float* xctx = (float*)(ws + WS_XC); const float* gate = (const float*)(ws + o_gate);
        bf16_t* xg = (bf16_t*)(ws + WS_XN); const float* gsc = (const float*)(ws + o_gsc); float* rss_out = (float*)(ws + o_rssout); float* part = (float*)(ws + o_part);
        if (u.kind == 1 || u.kind == 3) {
            const bool isv = u.kind == 3;
            const float* rsv = isv ? ckvss : rss1; const float rdv = isv ? (1.0f / 128.0f) : (1.0f / 1024.0f);
            const int cond = u.pn < 64 ? (u.pn >> 3) : 8;
            const int bsel = u.pn < 64 ? (u.pn >> 3) : (u.pn - 64), tok0 = u.pn < 64 ? (u.pn & 7) * 256 : 2048;
            f32x4 rs[2][2];
#pragma unroll
            for (int bj = 0; bj < 2; ++bj)
#pragma unroll
                for (int n = 0; n < 2; ++n) { const f32x4 q = *(const f32x4*)(rsv + col0 + bj * HALF + 4 * n);
#pragma unroll
                    for (int e4 = 0; e4 < 4; ++e4) rs[bj][n][e4] = __builtin_amdgcn_rsqf(q[e4] * rdv + 1e-6f); }
#pragma unroll
            for (int ai = 0; ai < 2; ++ai)
#pragma unroll
                for (int m = 0; m < 4; ++m) { const int rowc = row0 + ai * HALF + m * 16;
                    const float cbv = isv ? 0.f : sw[(size_t)cond * ldsw + rowc];
                    bf16_t* rowp;
                    if (isv) rowp = MVT + ((size_t)(bsel * 512 + rowc) * TOKB_ + tok0 + (col0 - u.pn * BM));
                    else if (u.pm < 3) rowp = PT + (size_t)rowc * NTOK_ + col0;
                    else rowp = NAVT + ((size_t)(bsel * 256 + (rowc - 768)) * TOKB_ + tok0 + (col0 - u.pn * BM));
#pragma unroll
                    for (int bj = 0; bj < 2; ++bj) { const f32x4 v0 = acc[ai][bj][m][0] * rs[bj][0] + cbv, v1 = acc[ai][bj][m][1] * rs[bj][1] + cbv;
                        u32x4 w; w.x = cvt_pk_bf16(v0[0], v0[1]); w.y = cvt_pk_bf16(v0[2], v0[3]); w.z = cvt_pk_bf16(v1[0], v1[1]); w.w = cvt_pk_bf16(v1[2], v1[3]);
                        *(u32x4*)(rowp + bj * HALF) = w; } }
            return;
        }
        if (u.kind == 2) {
            const int cond = u.pm < 64 ? (u.pm >> 3) : 8;
            const int bsel = u.pm < 64 ? (u.pm >> 3) : (u.pm - 64);
            f32x4 bv[2][2];
#pragma unroll
            for (int bj = 0; bj < 2; ++bj)
#pragma unroll
                for (int n = 0; n < 2; ++n) bv[bj][n] = *(const f32x4*)(sw + (size_t)cond * ldsw + 1024 + col0 + bj * HALF + 4 * n);
            const int cl = wc * 32 + 8 * fq;
#pragma unroll
            for (int ai = 0; ai < 2; ++ai)
#pragma unroll
                for (int m = 0; m < 4; ++m) { const int row = row0 + ai * HALF + m * 16;
                    const float rs = __builtin_amdgcn_rsqf(rss1[row] * (1.0f / 1024.0f) + 1e-6f);
                    const int tok = u.pm < 64 ? (row & 2047) : 2048 + (row & 255);
                    if (u.pn < 2) {
                        f32x4 v[2][2]; float ss = 0.f;
#pragma unroll
                        for (int bj = 0; bj < 2; ++bj)
#pragma unroll
                            for (int n = 0; n < 2; ++n) { v[bj][n] = acc[ai][bj][m][n] * rs + bv[bj][n]; const f32x4 t = v[bj][n]; ss += (t[0] * t[0] + t[1] * t[1]) + (t[2] * t[2] + t[3] * t[3]); }
                        ss += EPI_SHX(ss, 16); ss += EPI_SHX(ss, 32);
                        const float rn = __builtin_amdgcn_rsqf(ss * (1.0f / 64.0f) + 1e-6f) * (u.pn ? 1.0f : 0.125f * 1.4426950408889634f);
                        const float* gg = (u.pn ? nagk : nagq) + 8 * fq;
                        bf16_t* dst = (u.pn ? NAK : NAQ) + ((size_t)(bsel * 4 + wc) * TOKB_ + tok) * 64 + 8 * fq;
#pragma unroll
                        for (int bj = 0; bj < 2; ++bj) { const f32x4 v0 = v[bj][0] * *(const f32x4*)(gg + 32 * bj) * rn, v1 = v[bj][1] * *(const f32x4*)(gg + 32 * bj + 4) * rn;
                            u32x4 w; w.x = cvt_pk_bf16(v0[0], v0[1]); w.y = cvt_pk_bf16(v0[2], v0[3]); w.z = cvt_pk_bf16(v1[0], v1[1]); w.w = cvt_pk_bf16(v1[2], v1[3]);
                            *(u32x4*)(dst + 32 * bj) = w; }
                        continue; }
                    float ss0 = 0.f, ss1 = 0.f;
#pragma unroll
                    for (int bj = 0; bj < 2; ++bj) { const f32x4 v0 = acc[ai][bj][m][0] * rs + bv[bj][0], v1 = acc[ai][bj][m][1] * rs + bv[bj][1];
                        u32x4 w; w.x = cvt_pk_bf16(v0[0], v0[1]); w.y = cvt_pk_bf16(v0[2], v0[3]); w.z = cvt_pk_bf16(v1[0], v1[1]); w.w = cvt_pk_bf16(v1[2], v1[3]);
                        const float sq = ((v0[0] * v0[0] + v0[1] * v0[1]) + (v0[2] * v0[2] + v0[3] * v0[3])) + ((v1[0] * v1[0] + v1[1] * v1[1]) + (v1[2] * v1[2] + v1[3] * v1[3]));
                        if (bj == 0) ss0 = sq; else ss1 = sq;
                        const int cc = bj * HALF + cl;
                        if (u.pn == 2) { *(u32x4*)(CQ + (size_t)row * 256 + cc) = w; }
                        else { *(u32x4*)(CKV + (size_t)row * 256 + cc) = w;
                            if (bj == 1 && wc == 0) {
                                float kq = sq; kq += EPI_SHX(kq, 16); kq += EPI_SHX(kq, 32);
                                if (fq == 0) ((float*)(ws + WS_KRSS))[row] = kq;
                                const float* gkk = gk + 64 + 8 * fq; const f32x4 g0 = *(const f32x4*)gkk, g1 = *(const f32x4*)(gkk + 4);
                                f32x4 a0 = v0 * g0, a1 = v1 * g1;
                                f32x4 p0, p1;
#pragma unroll
                                for (int e4 = 0; e4 < 4; ++e4) { p0[e4] = EPI_SHX(a0[e4], 16); p1[e4] = EPI_SHX(a1[e4], 16); }
                                if (u.pm < 64) { const float* rp = (const float*)(ws + WS_ROPE) + (size_t)tok * 32 + (fq >> 1) * 8;
                                    const f32x4 c0 = *(const f32x4*)rp, c1 = *(const f32x4*)(rp + 4), s0 = *(const f32x4*)(rp + 16), s1 = *(const f32x4*)(rp + 20);
                                    if (fq & 1) { a0 = a0 * c0 + p0 * s0; a1 = a1 * c1 + p1 * s1; } else { a0 = a0 * c0 - p0 * s0; a1 = a1 * c1 - p1 * s1; } }
                                u32x4 wk; wk.x = cvt_pk_bf16(a0[0], a0[1]); wk.y = cvt_pk_bf16(a0[2], a0[3]); wk.z = cvt_pk_bf16(a1[0], a1[1]); wk.w = cvt_pk_bf16(a1[2], a1[3]);
                                *(u32x4*)(KR + (size_t)row * 32 + 8 * fq) = wk; } } }
                    if (u.pn >= 2) { float ss = u.pn == 2 ? ss0 + ss1 : ss0;
                        ss += EPI_SHX(ss, 16); ss += EPI_SHX(ss, 32);
                        if (fq == 0) EPI_ATOMIC((u.pn == 2 ? cqss : ckvss) + row, ss); } }
            return;
        }
        const unsigned k1 = 0u - (unsigned)(u.sub == 1), k2 = 0u - (unsigned)(u.sub == 2), k0 = ~(k1 | k2);
        const unsigned oO = (oO0 & k0) | (oO1 & k1) | (oO2 & k2); const int ldc = (int)(((unsigned)ldc0 & k0) | ((unsigned)ldc1 & k1) | ((unsigned)ldc2 & k2));
        const unsigned orss = (orss0 & k0) | (orss1 & k1) | (orss2 & k2);
        const float rdiv = __builtin_bit_cast(float, (__builtin_bit_cast(unsigned, rdiv0) & k0) | (__builtin_bit_cast(unsigned, rdiv1) & k1) | (__builtin_bit_cast(unsigned, rdiv2) & k2));
        bf16_t* O = (bf16_t*)(ws + oO); const float* rss = orss ? (const float*)(ws + orss) : nullptr;
        f32x4 bv[2][2];
#pragma unroll
        for (int bj = 0; bj < 2; ++bj)
#pragma unroll
            for (int n = 0; n < 2; ++n) bv[bj][n] = bias ? *(const f32x4*)(bias + col0 + bj * HALF + 4 * n) : (f32x4){0.f, 0.f, 0.f, 0.f};
        if (mode == 2) {
            const int cond = u.pm < 64 ? (u.pm >> 3) : 8;
            float* xb = u.pm < 64 ? xlat : (xctx - (size_t)16384 * 1024);
            f32x4 g[2][2];
#pragma unroll
            for (int bj = 0; bj < 2; ++bj)
#pragma unroll
                for (int n = 0; n < 2; ++n) g[bj][n] = *(const f32x4*)(gate + (size_t)cond * 6144 + col0 + bj * HALF + 4 * n);
            if (u.at) {
#pragma unroll
                for (int ai = 0; ai < 2; ++ai)
#pragma unroll
                    for (int m = 0; m < 4; ++m) { bf16_t* rowp = (bf16_t*)part + ((size_t)u.sp * 2048 + (size_t)(row0 + ai * HALF + m * 16 - 16384)) * 1024 + col0;
#pragma unroll
                        for (int bj = 0; bj < 2; ++bj) { const f32x4 v0 = acc[ai][bj][m][0], v1 = acc[ai][bj][m][1];
                            u32x4 w; w.x = cvt_pk_bf16(v0[0], v0[1]); w.y = cvt_pk_bf16(v0[2], v0[3]); w.z = cvt_pk_bf16(v1[0], v1[1]); w.w = cvt_pk_bf16(v1[2], v1[3]);
                            *(u32x4*)(rowp + bj * HALF) = w; } }
            } else if (!xgf) {
#pragma unroll
            for (int ai = 0; ai < 2; ++ai)
#pragma unroll
                for (int m = 0; m < 4; ++m) { float* rowp = xb + (size_t)(row0 + ai * HALF + m * 16) * 1024 + col0;
#pragma unroll
                    for (int bj = 0; bj < 2; ++bj)
#pragma unroll
                        for (int n = 0; n < 2; ++n) { f32x4* p = (f32x4*)(rowp + bj * HALF + 4 * n); const f32x4 xv = *(const f32x4*)((const char*)p + xdx); *p = xv + g[bj][n] * (acc[ai][bj][m][n] + bv[bj][n]); } }
            } else {
                f32x4 G[2][2];
#pragma unroll
                for (int bj = 0; bj < 2; ++bj)
#pragma unroll
                    for (int n = 0; n < 2; ++n) { const int cc = col0 + bj * HALF + 4 * n; G[bj][n] = *(const f32x4*)(gn + cc) * (*(const f32x4*)(gsc + (size_t)cond * 6144 + cc) + 1.0f); }
#pragma unroll
                for (int ai = 0; ai < 2; ++ai)
#pragma unroll
                    for (int m = 0; m < 4; ++m) { const int row = row0 + ai * HALF + m * 16; float* rowp = xb + (size_t)row * 1024 + col0; bf16_t* gp = xg + (size_t)row * 1024 + col0; float ss = 0.f;
#pragma unroll
                        for (int bj = 0; bj < 2; ++bj) { f32x4 xn[2];
#pragma unroll
                            for (int n = 0; n < 2; ++n) { f32x4* p = (f32x4*)(rowp + bj * HALF + 4 * n); const f32x4 xv = *(const f32x4*)((const char*)p + xdx); xn[n] = xv + g[bj][n] * (acc[ai][bj][m][n] + bv[bj][n]); *p = xn[n];
                                ss += (xn[n][0] * xn[n][0] + xn[n][1] * xn[n][1]) + (xn[n][2] * xn[n][2] + xn[n][3] * xn[n][3]); }
                            const f32x4 y0 = xn[0] * G[bj][0], y1 = xn[1] * G[bj][1];
                            u32x4 w; w.x = cvt_pk_bf16(y0[0], y0[1]); w.y = cvt_pk_bf16(y0[2], y0[3]); w.z = cvt_pk_bf16(y1[0], y1[1]); w.w = cvt_pk_bf16(y1[2], y1[3]);
                            *(u32x4*)(gp + bj * HALF) = w; }
                        ss += EPI_SHX(ss, 16); ss += EPI_SHX(ss, 32);
                        if (fq == 0) EPI_ATOMIC(rss_out + row, ss); }
            }
        } else {
            if (knf && u.sub == 1) {
                bf16_t* MK = (bf16_t*)(Ab + A_MK); const float* krss = (const float*)(ws + WS_KRSS);
                const int hh = u.pn * 4 + wc;
                f32x4 gg[2][2];
#pragma unroll
                for (int bj = 0; bj < 2; ++bj) { gg[bj][0] = *(const f32x4*)(gk + 32 * bj + 8 * fq); gg[bj][1] = *(const f32x4*)(gk + 32 * bj + 8 * fq + 4); }
#pragma unroll
                for (int ai = 0; ai < 2; ++ai)
#pragma unroll
                    for (int m = 0; m < 4; ++m) { const int row = row0 + ai * HALF + m * 16;
                        const float rs = __builtin_amdgcn_rsqf(rss[row] * rdiv + 1e-6f);
                        const u32x4 krw = *(const u32x4*)(KR + (size_t)row * 32 + 8 * fq);
                        const float krs = krss[row];
                        f32x4 v[2][2]; float kq = 0.f;
#pragma unroll
                        for (int bj = 0; bj < 2; ++bj)
#pragma unroll
                            for (int n = 0; n < 2; ++n) { v[bj][n] = acc[ai][bj][m][n] * rs; const f32x4 t = v[bj][n]; kq += (t[0] * t[0] + t[1] * t[1]) + (t[2] * t[2] + t[3] * t[3]); }
                        kq += EPI_SHX(kq, 16); kq += EPI_SHX(kq, 32);
                        const float rk = __builtin_amdgcn_rsqf((kq + krs) * (1.0f / 96.0f) + 1e-6f);
                        const int bb = u.pm < 64 ? (row >> 11) : ((row - 16384) >> 8), tok = u.pm < 64 ? (row & 2047) : 2048 + (row & 255);
                        bf16_t* dst = MK + ((size_t)(bb * 8 + hh) * TOKB_ + tok) * 96 + 8 * fq;
#pragma unroll
                        for (int bj = 0; bj < 2; ++bj) { const f32x4 v0 = v[bj][0] * gg[bj][0] * rk, v1 = v[bj][1] * gg[bj][1] * rk;
                            u32x4 w; w.x = cvt_pk_bf16(v0[0], v0[1]); w.y = cvt_pk_bf16(v0[2], v0[3]); w.z = cvt_pk_bf16(v1[0], v1[1]); w.w = cvt_pk_bf16(v1[2], v1[3]);
                            *(u32x4*)(dst + 32 * bj) = w; }
                        { u32x4 w;
                            w.x = cvt_pk_bf16(__builtin_bit_cast(float, krw.x << 16) * rk, __builtin_bit_cast(float, krw.x & 0xffff0000u) * rk); w.y = cvt_pk_bf16(__builtin_bit_cast(float, krw.y << 16) * rk, __builtin_bit_cast(float, krw.y & 0xffff0000u) * rk);
                            w.z = cvt_pk_bf16(__builtin_bit_cast(float, krw.z << 16) * rk, __builtin_bit_cast(float, krw.z & 0xffff0000u) * rk); w.w = cvt_pk_bf16(__builtin_bit_cast(float, krw.w << 16) * rk, __builtin_bit_cast(float, krw.w & 0xffff0000u) * rk);
                            *(u32x4*)(dst + 64) = w; } }
                return;
            }
            if (o_sw) { const int cond = u.pm < 64 ? (u.pm >> 3) : 8;
#pragma unroll
                for (int bj = 0; bj < 2; ++bj)
#pragma unroll
                    for (int n = 0; n < 2; ++n) bv[bj][n] = *(const f32x4*)(sw + (size_t)cond * ldsw + col0 + bj * HALF + 4 * n); }
#pragma unroll
            for (int ai = 0; ai < 2; ++ai)
#pragma unroll
                for (int m = 0; m < 4; ++m) { const int row = row0 + ai * HALF + m * 16; bf16_t* rowp = O + (size_t)row * ldc + col0;
                    const float rs = rss ? __builtin_amdgcn_rsqf(rss[row] * rdiv + 1e-6f) : 1.0f;
#pragma unroll
                    for (int bj = 0; bj < 2; ++bj) { f32x4 v0 = acc[ai][bj][m][0] * rs + bv[bj][0], v1 = acc[ai][bj][m][1] * rs + bv[bj][1];
                        if (mode == 1) {
#pragma unroll
                            for (int j = 0; j < 4; ++j) { const float a0 = v0[j] > 0.f ? v0[j] : 0.f, a1 = v1[j] > 0.f ? v1[j] : 0.f; v0[j] = a0 * a0; v1[j] = a1 * a1; } }
                        u32x4 w; w.x = cvt_pk_bf16(v0[0], v0[1]); w.y = cvt_pk_bf16(v0[2], v0[3]); w.z = cvt_pk_bf16(v1[0], v1[1]); w.w = cvt_pk_bf16(v1[2], v1[3]);
                        *(u32x4*)(rowp + bj * HALF) = w; } }
        }
    }
};

struct Order {
    const char* ws; unsigned A0, B0, A1, B1, A2, B2;
    int nM0, nN0, nM1, nN1, nM2, nN2, k0, k1, k2, n0, n1, n2, nMf, nrem, ksp, ntf, K, G, c;
    __device__ __forceinline__ void init(const char* ws_, const Sub& s0, const Sub& s1, const Sub& s2, int nsub, int K_, int ksplit, int G_, int c_) {
        ws = ws_; A0 = s0.A; B0 = s0.Bt; A1 = s1.A; B1 = s1.Bt; A2 = s2.A; B2 = s2.Bt; K = K_; ntf = K_ / BK; ksp = ksplit; G = G_; c = c_;
        nM0 = s0.M / BM; nN0 = s0.N / BM; k0 = s0.kind; nM1 = nsub > 1 ? s1.M / BM : 0; nN1 = nsub > 1 ? s1.N / BM : 1; k1 = s1.kind; nM2 = nsub > 2 ? s2.M / BM : 0; nN2 = nsub > 2 ? s2.N / BM : 1; k2 = s2.kind;
        nMf = (ksplit > 1 && nM0 > 64) ? 64 : nM0; n0 = nMf * nN0; nrem = (nM0 - nMf) * nN0; n1 = nM1 * nN1; n2 = nM2 * nN2;
    }
    static __device__ __forceinline__ void xmap(int L, int nM, int nN, int& pm, int& pn) {
        const int nwg = nM * nN; int wgid = L; { const int q = nwg / NXCD, r = nwg % NXCD, xcd = wgid % NXCD, off = wgid / NXCD; wgid = (xcd < r ? xcd * (q + 1) : r * (q + 1) + (xcd - r) * q) + off; }
        const int nig = WGM * nN, gid = wgid / nig, fm = gid * WGM, gsz = (nM - fm) < WGM ? (nM - fm) : WGM;
        pm = fm + ((wgid % nig) % gsz); pn = (wgid % nig) / gsz;
    }
    __device__ __forceinline__ bool next(int i_in, Unit& u) const {
        const bool swp = ksp > 1 && n0 == G && n1 == 0 && (nrem * ksp >= G ? (c & 1) : 1) && c < nrem * ksp && i_in < 2;
        const int i = swp ? 1 - i_in : i_in;
        const int L = i * G + c;
        int pm = 0, pn = 0, kb = 0, nt = ntf, sp = 0, at = 0, sub = 0, kind = k0; bool ok = true;
        if (L < n0) xmap(L, nMf, nN0, pm, pn);
        else if (L < n0 + n1) { sub = 1; kind = k1; xmap(L - n0, nM1, nN1, pm, pn); }
        else if (L < n0 + n1 + n2) { sub = 2; kind = k2; xmap(L - n0 - n1, nM2, nN2, pm, pn); }
        else { const int s = L - n0 - n1 - n2; ok = s < nrem * ksp;
            const int tile = s / ksp; sp = s % ksp; pm = nMf + tile / nN0; pn = tile % nN0; nt = ntf / ksp; kb = sp * nt; at = 1; }
        const unsigned k1m = 0u - (unsigned)(sub == 1), k2m = 0u - (unsigned)(sub == 2), k0m = ~(k1m | k2m);
        const unsigned Ao = (A0 & k0m) | (A1 & k1m) | (A2 & k2m), Bo = (B0 & k0m) | (B1 & k1m) | (B2 & k2m);
        u.A = ws + Ao + ((size_t)pm * BM * K + (size_t)kb * BK) * 2; u.B = ws + Bo + ((size_t)pn * BM * K + (size_t)kb * BK) * 2;
        u.pm = pm; u.pn = pn; u.nt = nt; u.sp = sp; u.at = at; u.sub = sub; u.kind = kind;
        return ok;
    }
    __device__ __forceinline__ void a_ready(const Unit&) const {}
    __device__ __forceinline__ void done(const Unit&) const {}
};

template <class Epi, class Sched, bool ALIGN_EPI = false, bool SP2 = false>
__device__ __forceinline__ void gemm_phase(PG8_LAS unsigned char* lds, const Gemm g, const Sched& S, const Epi& E) {
    unsigned ones_t = ~0u; asm volatile("" : "+s"(ones_t)); int tid_ = g.M * 64 + (int)__builtin_amdgcn_mbcnt_hi(ones_t, __builtin_amdgcn_mbcnt_lo(ones_t, 0u)); asm volatile("" : "+v"(tid_)); const int tid = tid_, wid = __builtin_amdgcn_readfirstlane(tid >> 6), lane = tid & 63, wr = wid >> 2, wc = wid & 3, fr = lane & 15, fq = lane >> 4;
    const int K = g.K;
    unsigned voffA[2], voffB[2];
#pragma unroll
    for (int i = 0; i < 2; ++i) { int R, C; stage_rc(tid * 16 + i * 8192, R, C); const int Rb = Epi::PERM ? ((R & ~31) + perm32(R & 31)) : R;
        voffA[i] = (unsigned)(R * K + C) * 2u; voffB[i] = (unsigned)(Rb * K + C) * 2u; }
    const size_t kstep = (size_t)(BK * 2);
    const size_t hstep = (size_t)HALF * K * 2;
    const size_t tstep = 2 * hstep;
    const unsigned ldsw = (unsigned)wid * 1024u;
    const int aoff = lds_byte(wr * 64 + fr, fq * 8), boff = lds_byte(wc * 32 + fr, fq * 8);
#define PG8_SA(b, h) (((b) * 2 + (h)) * HTB)
#define PG8_SB(b, h) ((4 + (b) * 2 + (h)) * HTB)
#define PG8_STAGE(bufoff, gbase, voff) do { _Pragma("unroll") for (int _i = 0; _i < 2; ++_i) \
        __builtin_amdgcn_global_load_lds((const unsigned*)((const char*)(gbase) + (voff)[_i]), (PG8_LAS unsigned*)(lds + (bufoff) + ldsw + _i * 8192), 16, 0, 0); } while (0)
#define PG8_LDA(dst, b, h) do { _Pragma("unroll") for (int m = 0; m < 4; ++m) _Pragma("unroll") for (int k = 0; k < 2; ++k) dst[m][k] = *(const PG8_LAS bf16x8*)(lds + PG8_SA(b, h) + aoff + m * 2048 + k * 1024); } while (0)
#define PG8_LDB(dst, b, h) do { _Pragma("unroll") for (int n = 0; n < 2; ++n) _Pragma("unroll") for (int k = 0; k < 2; ++k) dst[n][k] = *(const PG8_LAS bf16x8*)(lds + PG8_SB(b, h) + boff + n * 2048 + k * 1024); } while (0)
#define PG8_MMA(ai, bj, At, Bt) do { __builtin_amdgcn_s_setprio(1); _Pragma("unroll") for (int m = 0; m < 4; ++m) _Pragma("unroll") for (int n = 0; n < 2; ++n) _Pragma("unroll") for (int k = 0; k < 2; ++k) \
        acc[ai][bj][m][n] = __builtin_amdgcn_mfma_f32_16x16x32_bf16(Bt[n][k], At[m][k], acc[ai][bj][m][n], 0, 0, 0); __builtin_amdgcn_s_setprio(0); } while (0)
#define PG8_WAIT_V(n) asm volatile("s_waitcnt vmcnt(" #n ")" ::: "memory")
#define PG8_WAIT_L(n) asm volatile("s_waitcnt lgkmcnt(" #n ")" ::: "memory")
#define PG8_BAR __builtin_amdgcn_s_barrier()
#define PG8_SCHED __builtin_amdgcn_sched_barrier(0)
    Unit cur, nxt; int ui = 0;
    if (!S.next(0, cur)) return;
    f32x4 acc[2][2][4][2];
#pragma unroll
    for (int a = 0; a < 2; ++a)
#pragma unroll
        for (int b = 0; b < 2; ++b)
#pragma unroll
            for (int m = 0; m < 4; ++m)
#pragma unroll
                for (int n = 0; n < 2; ++n) acc[a][b][m][n] = (f32x4){0.f, 0.f, 0.f, 0.f};
    bf16x8 At[4][2], B0[2][2], B1[2][2];
    const char* cA = cur.A; const char* cB = cur.B;
    S.a_ready(cur);
    if constexpr (SP2) {
        PG8_STAGE(PG8_SB(0, 0), cB, voffB); PG8_STAGE(PG8_SB(0, 1), cB + hstep, voffB); PG8_STAGE(PG8_SA(0, 0), cA, voffA); PG8_STAGE(PG8_SA(0, 1), cA + hstep, voffA);
        if (wr == 1) PG8_BAR;
        PG8_WAIT_V(2); PG8_BAR;
        PG8_STAGE(PG8_SB(1, 0), cB + kstep, voffB); PG8_STAGE(PG8_SA(1, 0), cA + kstep, voffA); PG8_STAGE(PG8_SB(1, 1), cB + hstep + kstep, voffB);
        PG8_WAIT_V(6); PG8_BAR;
    } else {
        PG8_STAGE(PG8_SB(0, 0), cB, voffB); PG8_STAGE(PG8_SA(0, 0), cA, voffA); PG8_STAGE(PG8_SB(0, 1), cB + hstep, voffB); PG8_STAGE(PG8_SA(0, 1), cA + hstep, voffA);
        if (wr == 1) PG8_BAR;
        PG8_WAIT_V(4); PG8_BAR;
        PG8_STAGE(PG8_SB(1, 0), cB + kstep, voffB); PG8_STAGE(PG8_SA(1, 0), cA + kstep, voffA); PG8_STAGE(PG8_SB(1, 1), cB + hstep + kstep, voffB);
        PG8_WAIT_V(6); PG8_BAR;
    }
    for (;;) {
        const bool has_next = S.next(ui + 1, nxt);
        const char* nA = has_next ? nxt.A : cA; const char* nB = has_next ? nxt.B : cB;
        const int nt = cur.nt;
        for (int t = 0; t < nt; t += 2) {
            const bool last = (t == nt - 2);
            const char* a1 = cA + (size_t)(t + 1) * kstep;
            const char* a2 = last ? nA : cA + (size_t)(t + 2) * kstep; const char* b2 = last ? nB : cB + (size_t)(t + 2) * kstep;
            const char* a3 = a2 + kstep; const char* b3 = b2 + kstep;
            if (last && has_next) S.a_ready(nxt);
            if constexpr (SP2) {
            PG8_LDB(B0, 0, 0); PG8_LDB(B1, 0, 1); PG8_SCHED; PG8_LDA(At, 0, 0); PG8_STAGE(PG8_SA(1, 1), a1 + hstep, voffA);
            PG8_WAIT_V(8); PG8_WAIT_L(0); PG8_BAR; PG8_MMA(0, 0, At, B0); PG8_MMA(0, 1, At, B1); PG8_BAR; PG8_SCHED;
            PG8_LDA(At, 0, 1); PG8_STAGE(PG8_SB(0, 0), b2, voffB); PG8_STAGE(PG8_SB(0, 1), b2 + hstep, voffB); PG8_STAGE(PG8_SA(0, 0), a2, voffA);
            PG8_WAIT_V(8); PG8_WAIT_L(0); PG8_BAR; PG8_MMA(1, 0, At, B0); PG8_MMA(1, 1, At, B1); PG8_BAR; PG8_SCHED;
            PG8_LDB(B0, 1, 0); PG8_LDB(B1, 1, 1); PG8_SCHED; PG8_LDA(At, 1, 0); PG8_STAGE(PG8_SA(0, 1), a2 + hstep, voffA);
            PG8_WAIT_V(8); PG8_WAIT_L(0); PG8_BAR; PG8_MMA(0, 0, At, B0); PG8_MMA(0, 1, At, B1); PG8_BAR; PG8_SCHED;
            PG8_LDA(At, 1, 1); PG8_STAGE(PG8_SB(1, 0), b3, voffB); PG8_STAGE(PG8_SB(1, 1), b3 + hstep, voffB); PG8_STAGE(PG8_SA(1, 0), a3, voffA);
            PG8_WAIT_V(8); PG8_WAIT_L(0); PG8_BAR; PG8_MMA(1, 0, At, B0); PG8_MMA(1, 1, At, B1); PG8_BAR; PG8_SCHED;
            } else {
            PG8_LDB(B0, 0, 0); PG8_SCHED; PG8_LDA(At, 0, 0); PG8_STAGE(PG8_SA(1, 1), a1 + hstep, voffA);
            PG8_WAIT_L(8); PG8_BAR; PG8_WAIT_L(0); PG8_MMA(0, 0, At, B0); PG8_BAR; PG8_SCHED;
            PG8_LDB(B1, 0, 1); PG8_STAGE(PG8_SB(0, 0), b2, voffB);
            PG8_BAR; PG8_WAIT_L(0); PG8_MMA(0, 1, At, B1); PG8_BAR;
            PG8_LDA(At, 0, 1); PG8_STAGE(PG8_SA(0, 0), a2, voffA);
            PG8_BAR; PG8_WAIT_L(0); PG8_MMA(1, 0, At, B0); PG8_BAR; PG8_SCHED;
            PG8_STAGE(PG8_SB(0, 1), b2 + hstep, voffB);
            PG8_WAIT_V(6); PG8_BAR; PG8_MMA(1, 1, At, B1); PG8_BAR;
            PG8_LDB(B0, 1, 0); PG8_SCHED; PG8_LDA(At, 1, 0); PG8_STAGE(PG8_SA(0, 1), a2 + hstep, voffA);
            PG8_WAIT_L(8); PG8_BAR; PG8_WAIT_L(0); PG8_MMA(0, 0, At, B0); PG8_BAR; PG8_SCHED;
            PG8_LDB(B1, 1, 1); PG8_STAGE(PG8_SB(1, 0), b3, voffB);
            PG8_BAR; PG8_WAIT_L(0); PG8_MMA(0, 1, At, B1); PG8_BAR;
            PG8_LDA(At, 1, 1); PG8_STAGE(PG8_SA(1, 0), a3, voffA);
            PG8_BAR; PG8_WAIT_L(0); PG8_MMA(1, 0, At, B0); PG8_BAR; PG8_SCHED;
            PG8_STAGE(PG8_SB(1, 1), b3 + hstep, voffB);
            PG8_WAIT_V(6); PG8_BAR; PG8_MMA(1, 1, At, B1); PG8_BAR;
            }
        }
        if constexpr (ALIGN_EPI) { if (wr == 0) PG8_BAR; }
        if constexpr (!Epi::AFTER_DRAIN) { E(acc, cur, wr, wc, fr, fq); S.done(cur); }
        if (!has_next) break;
#pragma unroll
        for (int a = 0; a < 2; ++a)
#pragma unroll
            for (int b = 0; b < 2; ++b)
#pragma unroll
                for (int m = 0; m < 4; ++m)
#pragma unroll
                    for (int n = 0; n < 2; ++n) acc[a][b][m][n] = (f32x4){0.f, 0.f, 0.f, 0.f};
        cur = nxt; cA = nA; cB = nB; ++ui;
        if constexpr (ALIGN_EPI) { if (wr == 1) PG8_BAR; }
    }
    PG8_WAIT_V(0);
    if constexpr (!ALIGN_EPI) { if (wr == 0) PG8_BAR; }
    PG8_BAR;
    if constexpr (Epi::AFTER_DRAIN) { E.fused(acc, cur, wr, wc, fr, fq, lds, wid, lane); S.done(cur); }
#undef PG8_SA
#undef PG8_SB
#undef PG8_STAGE
#undef PG8_LDA
#undef PG8_LDB
#undef PG8_MMA
#undef PG8_WAIT_V
#undef PG8_WAIT_L
#undef PG8_BAR
#undef PG8_SCHED
}
}

__device__ __forceinline__ unsigned f2bf(float f) { unsigned u = __builtin_bit_cast(unsigned, f); return (u + 0x7fffu + ((u >> 16) & 1u)) >> 16; }
typedef float f32x2_t __attribute__((ext_vector_type(2))); typedef __bf16 bf16x2_t __attribute__((ext_vector_type(2)));
__device__ __forceinline__ unsigned pk2(float lo, float hi) { f32x2_t v = {lo, hi}; bf16x2_t b = __builtin_convertvector(v, bf16x2_t); return __builtin_bit_cast(unsigned, b); }
__device__ __forceinline__ float bf2f(unsigned h) { return __builtin_bit_cast(float, h << 16); }
__device__ __forceinline__ float bflo(unsigned w) { return __builtin_bit_cast(float, w << 16); }
__device__ __forceinline__ float bfhi(unsigned w) { return __builtin_bit_cast(float, w & 0xffff0000u); }
template <int M> __device__ __forceinline__ float xpart(float v) {
    const int u = __builtin_bit_cast(int, v);
    if constexpr (M == 1) return __builtin_bit_cast(float, __builtin_amdgcn_update_dpp(u, u, 0xB1, 0xF, 0xF, false));
    else if constexpr (M == 2) return __builtin_bit_cast(float, __builtin_amdgcn_update_dpp(u, u, 0x4E, 0xF, 0xF, false));
    else return __builtin_bit_cast(float, __builtin_amdgcn_ds_swizzle(u, (M << 10) | 0x1F));
}
__device__ __forceinline__ float xsum32(float v) { const unsigned u = __builtin_bit_cast(unsigned, v); auto rr = __builtin_amdgcn_permlane32_swap(u, u, false, false);
    return __builtin_bit_cast(float, (unsigned)rr[0]) + __builtin_bit_cast(float, (unsigned)rr[1]); }
__device__ __forceinline__ float xmax32(float v) { const unsigned u = __builtin_bit_cast(unsigned, v); auto rr = __builtin_amdgcn_permlane32_swap(u, u, false, false);
    return fmaxf(__builtin_bit_cast(float, (unsigned)rr[0]), __builtin_bit_cast(float, (unsigned)rr[1])); }
__device__ __forceinline__ float xor32(float v, int hf) { const unsigned u = __builtin_bit_cast(unsigned, v); auto rr = __builtin_amdgcn_permlane32_swap(u, u, false, false);
    return __builtin_bit_cast(float, hf ? (unsigned)rr[0] : (unsigned)rr[1]); }
__device__ __forceinline__ float wave_sum(float v) {
    v += xpart<1>(v); v += xpart<2>(v); v += xpart<4>(v); v += xpart<8>(v); v += xpart<16>(v); v = xsum32(v);
    return v;
}
__device__ __forceinline__ int lane_now() { unsigned ones_ = ~0u; asm volatile("" : "+s"(ones_)); return (int)__builtin_amdgcn_mbcnt_hi(ones_, __builtin_amdgcn_mbcnt_lo(ones_, 0u)); }
__device__ __forceinline__ int ltid(const Args& a) { int t = a.wv * 64 + lane_now(); asm volatile("" : "+v"(t)); return t; }
__device__ __forceinline__ int crow(int r, int hi) { return (r & 3) + 8 * (r >> 2) + 4 * hi; }

__device__ __forceinline__ void row_bt(int row, int& b, int& tok) {
    if (row < NLAT) { b = row >> 11; tok = row & 2047; } else { const int r = row - NLAT; b = r >> 8; tok = SEQ + (r & 255); }
}

__device__ __forceinline__ int na_perm(int j) { return 32 * (j >> 6) + (j & 31) + 128 * ((j >> 5) & 1); }
__device__ __forceinline__ int inproj_row(int n) { return n < 768 ? n : (n < 1024 ? 1024 + na_perm(n - 768) : (n < 1280 ? 1280 + na_perm(n - 1024) : (n < 1536 ? n - 512 : n))); }
__device__ __forceinline__ void transpose_item(const float* W, int N, bf16_t* WT, int ldk, float* scr, int item, int lane, bool remap = false) {
    const int nblk = N / 32, kb = item / nblk, nb = item % nblk, k0 = 64 * kb, n0 = 32 * nb, d0 = remap ? inproj_row(n0) : n0;
    float tv[32];
#pragma unroll
    for (int i = 0; i < 32; ++i) tv[i] = W[(size_t)(k0 + 2 * i + (lane >> 5)) * N + n0 + (lane & 31)];
#pragma unroll
    for (int i = 0; i < 32; ++i) scr[(2 * i + (lane >> 5)) * 33 + (lane & 31)] = tv[i];
    asm volatile("s_waitcnt lgkmcnt(0)" ::: "memory");
    const int c = lane & 7;
#pragma unroll
    for (int j = 0; j < 4; ++j) { const int n = (lane >> 3) + 8 * j; const float* s = scr + (8 * c) * 33 + n;
        u32x4 o; o.x = pk2(s[0 * 33], s[1 * 33]); o.y = pk2(s[2 * 33], s[3 * 33]); o.z = pk2(s[4 * 33], s[5 * 33]); o.w = pk2(s[6 * 33], s[7 * 33]);
        *(u32x4*)(WT + (size_t)(d0 + n) * ldk + k0 + 8 * c) = o; }
    asm volatile("s_waitcnt lgkmcnt(0)" ::: "memory");
}

__device__ __forceinline__ void vecmat9(const Args& a, unsigned char* lds_g, const float* W, int ldw, int ncol_valid, int cb, const float* bias, float* dest, int ldd, int dcb, bool perm = false) {
    const int tid = ltid(a), lane = tid & 63, wave = tid >> 6;
    const float* sl = (const float*)lds_g; float* red = (float*)(lds_g + 9 * 1024 * 4);
    const int n = cb * 256 + 4 * lane; const bool okc = n < ncol_valid;
    f32x4 acc[9];
#pragma unroll
    for (int c = 0; c < 9; ++c) acc[c] = (f32x4){0.f, 0.f, 0.f, 0.f};
    if (okc) { const float* wm = W + n + (size_t)(wave * 128) * ldw;
        f32x4 wc[16], wn[16];
#pragma unroll
        for (int j = 0; j < 16; ++j) wc[j] = *(const f32x4*)(wm + (size_t)j * ldw);
#pragma unroll 1
        for (int kk0 = 0; kk0 < 128; kk0 += 16) {
            const int kn = kk0 + 16 < 128 ? kk0 + 16 : kk0;
#pragma unroll
            for (int j = 0; j < 16; ++j) wn[j] = *(const f32x4*)(wm + (size_t)(kn + j) * ldw);
#pragma unroll
            for (int j = 0; j < 16; ++j) { const int k = wave * 128 + kk0 + j;
#pragma unroll
                for (int c = 0; c < 9; ++c) acc[c] += wc[j] * sl[c * 1024 + k]; }
#pragma unroll
            for (int j = 0; j < 16; ++j) wc[j] = wn[j];
        } }
#pragma unroll
    for (int c = 0; c < 9; ++c) *(f32x4*)(red + (wave * 9 + c) * 256 + 4 * lane) = acc[c];
    __syncthreads();
    for (int i = tid; i < 9 * 256; i += NTHREADS) { const int c = i >> 8, j = i & 255; float s = bias ? bias[cb * 256 + j] : 0.f;
#pragma unroll
        for (int w = 0; w < 8; ++w) s += red[(w * 9 + c) * 256 + j];
        dest[(size_t)c * ldd + dcb * 256 + (perm ? na_perm(j) : j)] = s; }
    __syncthreads();
}

__device__ __forceinline__ void wconv_layer(const Args& a, int layer, int vw, int NV, unsigned char* lds_g) {
    const int lane = ltid(a) & 63, wave = ltid(a) >> 6;
    float* scr = (float*)lds_g + wave * (64 * 33);
    constexpr int IT_IN = 16 * 61, IT_OUT = 16 * 32, IT_F1 = 16 * 128, IT_F2 = 64 * 32, IT_L = IT_IN + IT_OUT + IT_F1 + IT_F2;
    unsigned char* wl = a.ws + WS_W + (size_t)layer * W_LAYER;
    if (vw < 0) return;
    for (int r0 = vw; r0 < IT_L; r0 += NV) { int r = r0;
        if (r < IT_IN) { transpose_item(a.in[I_WIN] + (size_t)layer * 1024 * 1952, 1952, (bf16_t*)(wl + W_IN), 1024, scr, r, lane, true); continue; } r -= IT_IN;
        if (r < IT_OUT) { transpose_item(a.in[I_WOUT] + (size_t)layer * 1024 * 1024, 1024, (bf16_t*)(wl + W_OUT), 1024, scr, r, lane); continue; } r -= IT_OUT;
        if (r < IT_F1) { transpose_item(a.in[I_WFF1] + (size_t)layer * 1024 * 4096, 4096, (bf16_t*)(wl + W_FF1), 1024, scr, r, lane); continue; } r -= IT_F1;
        transpose_item(a.in[I_WFF2] + (size_t)layer * 4096 * 1024, 1024, (bf16_t*)(wl + W_FF2), 4096, scr, r, lane);
    }
}

__device__ __forceinline__ void phase0(const Args& a, unsigned char* lds_g) {
    const int tid = ltid(a), lane = tid & 63, wave = tid >> 6;
    const int gw = blockIdx.x * 8 + wave, NGW = gridDim.x * 8;
    const int gt = blockIdx.x * NTHREADS + tid, NGT = gridDim.x * NTHREADS;
    unsigned char* ws = a.ws;
    {
        float* sl = (float*)lds_g;
        for (int i = tid; i < 9 * 1024; i += NTHREADS) { const int cnd = i >> 10, k = i & 1023; const float v = cnd < 8 ? a.in[I_C][cnd * 1024 + k] : a.in[I_CCTX][k]; sl[i] = v / (1.f + __expf(-v)); }
        __syncthreads();
        for (int it = blockIdx.x; it < DEPTH * 24; it += gridDim.x) {
            const int layer = it / 24, cb = it % 24;
            vecmat9(a, lds_g, a.in[I_WMOD] + (size_t)layer * 1024 * 6144, 6144, 6144, cb, a.in[I_BMOD] + layer * 6144, (float*)(ws + WS_MOD) + (size_t)layer * 9 * 6144, 6144, cb);
        }
        __syncthreads();
    }
    { const int nA = DEPTH * 24 < (int)gridDim.x ? DEPTH * 24 : 0;
        wconv_layer(a, 0, ((int)blockIdx.x - nA) * 8 + wave, ((int)gridDim.x - nA) * 8, lds_g); }
    for (int i = gt; i < DEPTH * 1024 * 256; i += NGT) {
        const int layer = i >> 18, n = (i >> 8) & 1023, k = i & 255; unsigned char* wl = ws + WS_W + (size_t)layer * W_LAYER;
        if (n < 768) ((bf16_t*)(wl + W_Q))[n * 256 + k] = (bf16_t)f2bf(a.in[I_WQUP][((size_t)layer * 256 + k) * 768 + n] * a.in[I_GQA][layer * 256 + k]);
        const int nn = n & 255, hk = ((n & 511) >> 8) * 4 + ((nn >> 5) & 3), dk = 32 * (nn >> 7) + (nn & 31);
        const int hs = (n & 511) >> 6, is = n & 63, srcc = n < 512 ? hk * 128 + dk : hs * 128 + 64 + is;
        float vk = 0.f; if (k < 128) vk = a.in[I_WKVUP][((size_t)layer * 128 + k) * 1024 + srcc] * a.in[I_GKVA][layer * 128 + k];
        ((bf16_t*)(wl + W_KV))[n * 256 + k] = (bf16_t)f2bf(vk);
    }
    for (int i = gt; i < DEPTH * 96 * 1024 / 2; i += NGT) { const int layer = i / (96 * 512), r = i % (96 * 512);
        ((unsigned*)(ws + WS_W + (size_t)layer * W_LAYER + W_IN))[1952 * 512 + r] = 0u; }
    for (int p = gw; p < DEPTH * TOKB; p += NGW) {
        const int layer = p / TOKB, l2 = p % TOKB; const bool isc = l2 >= SEQ; const int L = isc ? CTXL : SEQ, l = isc ? l2 - SEQ : l2;
        const float t = (float)l / (float)(L - 1), w = (6.283185307179586f / (float)L) * (float)l;
        const float* w1 = a.in[I_HW1] + layer * 17 * 64; const float* w2 = a.in[I_HW2] + layer * 64 * 64; const float* fr = a.in[I_HFREQ] + layer * 128;
        float s1 = a.in[I_HB1][layer * 64 + lane] + t * w1[lane];
#pragma unroll
        for (int i = 0; i < 8; ++i) { const float band = 1e-4f + (float)i * ((7.0f - 1e-4f) / 7.0f), ang = band * w;
            s1 += cosf(ang) * w1[(1 + i) * 64 + lane] - sinf(ang) * w1[(9 + i) * 64 + lane]; }
        const float h1 = sinf(fr[lane] * s1);
        float s2 = a.in[I_HB2][layer * 64 + lane];
#pragma unroll
        for (int k = 0; k < 64; ++k) s2 += __builtin_bit_cast(float, __builtin_amdgcn_readlane(__builtin_bit_cast(int, h1), k)) * w2[k * 64 + lane];
        ((float*)(ws + WS_HDN2))[((size_t)layer * TOKB + l2) * 64 + lane] = sinf(fr[64 + lane] * s2);
    }
    for (int i = gt; i < SEQ * 16; i += NGT) { const int s = i >> 4, af = i & 15, ax = af >> 3, f = af & 7;
        const float pos = (float)(ax == 0 ? (s >> 6) : (s & 63)), inv = powf(10000.0f, -(float)f / 8.0f), ang = pos * inv;
        ((float*)(ws + WS_ROPE))[s * 32 + af] = cosf(ang); ((float*)(ws + WS_ROPE))[s * 32 + 16 + af] = sinf(ang); }
}

__device__ __forceinline__ void prenorm_pass(const Args& a, int layer, int which  , int row_lo, int row_hi,
                                             const float* part, int nsplit, const float* pgate, const float* pbias, float* rss, float* rss_zero, const float* xin_lat, const float* xin_ctx, int skipb = 0) {
    const int lane = ltid(a) & 63, wave = ltid(a) >> 6, gw = blockIdx.x * 8 + wave, NGW = gridDim.x * 8;
    const float* g = a.in[which ? I_GN2 : I_GN1] + layer * DM;
    const float* mod = (const float*)(a.ws + WS_MOD) + (size_t)layer * 9 * 6144;
    bf16_t* XN = (bf16_t*)(a.ws + WS_XN);
    float zf = 0.f; asm volatile("" : "+v"(zf)); const f32x4 z4 = {zf, zf, zf, zf};
    for (int i = blockIdx.x * NTHREADS + ltid(a); i < NLAT / 4; i += gridDim.x * NTHREADS) ((f32x4*)rss_zero)[i] = z4;
    if (which == 0) { for (int i = blockIdx.x * NTHREADS + ltid(a); i < NTOK / 4; i += gridDim.x * NTHREADS) { ((f32x4*)(a.ws + WS_CQSS))[i] = z4; ((f32x4*)(a.ws + WS_CKVSS))[i] = z4; }
        }
    if ((int)blockIdx.x >= skipb)
    for (int row = row_lo + gw - skipb * 8; row < row_hi; row += NGW - skipb * 8) {
        float* xr = row < NLAT ? a.out + (size_t)row * DM : (float*)(a.ws + WS_XC) + (size_t)(row - NLAT) * DM;
        const float* xs = row < NLAT ? xin_lat + (size_t)row * DM : xin_ctx + (size_t)(row - NLAT) * DM;
        const int cond = row < NLAT ? (row >> 11) : 8;
        const float* sc = mod + cond * 6144 + (which ? 4 : 1) * 1024;
        const bool pend = nsplit > 0 && row >= NLAT;
        f32x4 v[4]; float ss = 0.f;
#pragma unroll
        for (int j = 0; j < 4; ++j) { v[j] = ((const f32x4*)xs)[64 * j + lane];
            if (pend) { const int c = 4 * (64 * j + lane); f32x4 sm = pbias ? *(const f32x4*)(pbias + c) : (f32x4){0.f, 0.f, 0.f, 0.f};
                for (int sp = 0; sp < nsplit; ++sp) { const u32x2 pq = *(const u32x2*)((const bf16_t*)part + ((size_t)sp * 2048 + (row - NLAT)) * 1024 + c);
                    sm += (f32x4){bflo(pq.x), bfhi(pq.x), bflo(pq.y), bfhi(pq.y)}; }
                v[j] += *(const f32x4*)(pgate + c) * sm; ((f32x4*)xr)[64 * j + lane] = v[j]; }
            ss += (v[j].x * v[j].x + v[j].y * v[j].y) + (v[j].z * v[j].z + v[j].w * v[j].w); }
        ss = wave_sum(ss);
        if (lane == 0) rss[row] = ss;
#pragma unroll
        for (int j = 0; j < 4; ++j) { const int c = 4 * (64 * j + lane);
            const f32x4 gg = *(const f32x4*)(g + c), s1 = *(const f32x4*)(sc + c);
            const f32x4 o = v[j] * gg * (s1 + 1.0f);
            u32x2 w; w.x = pk2(o.x, o.y); w.y = pk2(o.z, o.w);
            *(u32x2*)(XN + (size_t)row * DM + c) = w; }
    }
}
__device__ __forceinline__ void tap_phase(const Args& a, unsigned char* lds_g) {
    const int tid = ltid(a);
    float* hs = (float*)lds_g;
    for (int item = blockIdx.x; item < DEPTH * 64; item += gridDim.x) {
        const int layer = item >> 6, p0 = (item & 63) * 36;
        const float* H = (const float*)(a.ws + WS_HDN2) + ((size_t)layer * TOKB + p0) * 64;
        for (int i = tid; i < 36 * 64 / 4; i += NTHREADS) ((f32x4*)hs)[i] = ((const f32x4*)H)[i];
        const float* w3 = a.in[I_HW3] + (size_t)layer * 64 * 1024 + tid;
        float acc0[36], acc1[36];
        { const float b0 = a.in[I_HB3][layer * 1024 + tid], b1 = a.in[I_HB3][layer * 1024 + 512 + tid];
#pragma unroll
            for (int p = 0; p < 36; ++p) { acc0[p] = b0; acc1[p] = b1; } }
        float wc0[4], wc1[4], wn0[4], wn1[4];
#pragma unroll
        for (int e = 0; e < 4; ++e) { wc0[e] = w3[(size_t)e * 1024]; wc1[e] = w3[(size_t)e * 1024 + 512]; }
        __syncthreads();
#pragma unroll 1
        for (int k4 = 0; k4 < 16; ++k4) {
            const int kn = k4 + 1 < 16 ? k4 + 1 : k4;
#pragma unroll
            for (int e = 0; e < 4; ++e) { wn0[e] = w3[(size_t)(4 * kn + e) * 1024]; wn1[e] = w3[(size_t)(4 * kn + e) * 1024 + 512]; }
#pragma unroll
            for (int p = 0; p < 36; ++p) { const f32x4 h = *(const f32x4*)(hs + p * 64 + 4 * k4);
#pragma unroll
                for (int e = 0; e < 4; ++e) { acc0[p] += h[e] * wc0[e]; acc1[p] += h[e] * wc1[e]; } }
#pragma unroll
            for (int e = 0; e < 4; ++e) { wc0[e] = wn0[e]; wc1[e] = wn1[e]; }
        }
        const float lo = -4.605170185988091f / 1.5f, hi = -4.605170185988091f / 0.3f;
        const float adelta = fabsf(lo + (float)(tid & 255) * ((hi - lo) / 255.0f));
        bf16_t* d0 = (bf16_t*)(a.ws + WS_KTAP) + ((size_t)layer * 1024 + tid) * TOKB + p0; bf16_t* d1 = d0 + (size_t)512 * TOKB;
#pragma unroll
        for (int p = 0; p < 36; p += 4) { unsigned w0[2], w1[2];
#pragma unroll
            for (int q2 = 0; q2 < 2; ++q2) { float v0[2], v1[2];
#pragma unroll
                for (int j = 0; j < 2; ++j) { const int pos = p0 + p + 2 * q2 + j; const bool isc = pos >= SEQ;
                    const float t = isc ? (float)(pos - SEQ) / (float)(CTXL - 1) : (float)pos / (float)(SEQ - 1), dec = expf(-t * adelta);
                    v0[j] = acc0[p + 2 * q2 + j] * dec; v1[j] = acc1[p + 2 * q2 + j] * dec; }
                w0[q2] = pk2(v0[0], v0[1]); w1[q2] = pk2(v1[0], v1[1]); }
            *(u32x2*)(d0 + p) = (u32x2){w0[0], w0[1]}; *(u32x2*)(d1 + p) = (u32x2){w1[0], w1[1]}; }
        __syncthreads();
    }
}
__device__ __forceinline__ void sw_phase(const Args& a, unsigned char* lds_g) {
    float* sl = (float*)lds_g;
    for (int it = blockIdx.x; it < DEPTH * 24; it += gridDim.x) {
        const int layer = it / 24, r = it % 24; const bool ff = r >= 8; const int cb = ff ? r - 8 : r;
        const float* mod = (const float*)(a.ws + WS_MOD) + (size_t)layer * 9 * 6144;
        for (int i = ltid(a); i < 9 * 1024; i += NTHREADS) sl[i] = mod[(i >> 10) * 6144 + (ff ? 3 : 0) * 1024 + (i & 1023)];
        __syncthreads();
        if (ff) vecmat9(a, lds_g, a.in[I_WFF1] + (size_t)layer * 1024 * 4096, 4096, 4096, cb, a.in[I_BFF1] + layer * DFF, (float*)(a.ws + WS_SW2) + (size_t)layer * 9 * 4096, 4096, cb);
        else vecmat9(a, lds_g, a.in[I_WIN] + (size_t)layer * 1024 * 1952, 1952, 1952, cb, nullptr, (float*)(a.ws + WS_SW1) + (size_t)layer * 9 * 2048, 2048, cb < 3 ? cb : (cb == 3 ? 4 : (cb == 4 ? 5 : (cb == 5 ? 3 : cb))), cb == 3 || cb == 4);
    }
    __syncthreads();
}

template <int R, int C>
__device__ __forceinline__ void transpose_tile(const Args& a, const bf16_t* src, size_t ld_s, bf16_t* dst, size_t ld_d, unsigned char* lds_g) {
    static_assert(R % 8 == 0 && C % 8 == 0, "tile");
    constexpr int LDT = C + 2;
    constexpr int NCH = R * C / 8, NI = (NCH + NTHREADS - 1) / NTHREADS;
    unsigned* t32 = (unsigned*)lds_g; const bf16_t* t16 = (const bf16_t*)lds_g;
    const int tid = ltid(a);
#pragma unroll
    for (int i = 0; i < NI; ++i) { const int q = tid + NTHREADS * i, r = q / (C / 8), part = q % (C / 8);
        if (NCH % NTHREADS == 0 || q < NCH) {
        const u32x4 v = *(const u32x4*)(src + (size_t)r * ld_s + part * 8);
        unsigned* d = t32 + (r * LDT + part * 8) / 2; d[0] = v.x; d[1] = v.y; d[2] = v.z; d[3] = v.w; } }
    __syncthreads();
#pragma unroll
    for (int i = 0; i < NI; ++i) { const int p = tid + NTHREADS * i, chunk = p % (R / 8), c = p / (R / 8);
        if (NCH % NTHREADS == 0 || p < NCH) {
        unsigned short e[8];
#pragma unroll
        for (int k = 0; k < 8; ++k) e[k] = t16[(8 * chunk + k) * LDT + c];
        u32x4 o; o.x = e[0] | ((unsigned)e[1] << 16); o.y = e[2] | ((unsigned)e[3] << 16); o.z = e[4] | ((unsigned)e[5] << 16); o.w = e[6] | ((unsigned)e[7] << 16);
        *(u32x4*)(dst + (size_t)c * ld_d + 8 * chunk) = o; } }
    __syncthreads();
}

__device__ __forceinline__ void unpack8(const u32x4 w, float (&x)[8]) {
    x[0] = bflo(w.x); x[1] = bfhi(w.x); x[2] = bflo(w.y); x[3] = bfhi(w.y); x[4] = bflo(w.z); x[5] = bfhi(w.z); x[6] = bflo(w.w); x[7] = bfhi(w.w);
}
__device__ __forceinline__ u32x4 pack8(const float (&x)[8]) { u32x4 o; o.x = pk2(x[0], x[1]); o.y = pk2(x[2], x[3]); o.z = pk2(x[4], x[5]); o.w = pk2(x[6], x[7]); return o; }
__device__ __forceinline__ void mla_unit(const Args& a, int layer, int b, int h, int qb, unsigned char* lds_g) {
    const int tid = ltid(a), lane = tid & 63, wave = __builtin_amdgcn_readfirstlane(tid >> 6), q = lane & 31, hf = lane >> 5;
    unsigned char* A = a.ws + WS_A;
    const bf16_t* QP = (const bf16_t*)(A + A_QP);
    const bf16_t* Kb = (const bf16_t*)(A + A_MK) + (size_t)(b * 8 + h) * TOKB * 96;
    const bf16_t* VTb = (const bf16_t*)(A + A_MVT) + (size_t)(b * 8 + h) * 64 * TOKB;
    bf16_t* MIX = (bf16_t*)(a.ws + WS_A + A_MIX);
    const float* gq = a.in[I_MGQ] + layer * 96;
    const float* ropet = (const float*)(a.ws + WS_ROPE);
    const bool isctx = qb == 8;
    const int t_lo = isctx ? 32 : 0, t_hi = 36;
    const int qpos = qb * 256 + wave * 32 + q;
    const int qrow = isctx ? NLAT + b * CTXL + wave * 32 + q : b * SEQ + qpos;
    constexpr int KSTR = 208, VSTR = 144, KBUF = 64 * KSTR, VBUF = 64 * VSTR;
    constexpr float THR = 6.0f;
    unsigned char* Ks = lds_g; unsigned char* Vs = lds_g + 2 * KBUF;
    u32x4 kA0, kA1, kB0, kB1, vA, vB;
    const int kc0 = tid, kc1 = 512 + (tid & 255);
    const int vd = tid >> 3, vpart = tid & 7;
#define MLA_LOADK(t, S) do { const int tc_ = (t) < t_hi ? (t) : t_hi - 1; const bf16_t* ksrc = Kb + (size_t)tc_ * 64 * 96; k##S##0 = *(const u32x4*)(ksrc + kc0 * 8); k##S##1 = *(const u32x4*)(ksrc + kc1 * 8); } while (0)
#define MLA_LOADV(t, S) do { const int tc_ = (t) < t_hi ? (t) : t_hi - 1; v##S = *(const u32x4*)(VTb + (size_t)vd * TOKB + tc_ * 64 + vpart * 8); } while (0)
#define MLA_STOREK(buf, S) do { *(u32x4*)(Ks + (buf) * KBUF + (kc0 / 12) * KSTR + (kc0 % 12) * 16) = k##S##0; *(u32x4*)(Ks + (buf) * KBUF + (kc1 / 12) * KSTR + (kc1 % 12) * 16) = k##S##1; } while (0)
#define MLA_STOREV(buf, S) do { unsigned char* vd_ = Vs + (buf) * VBUF + vd * VSTR + (vpart >> 1) * 32 + (vpart & 1) * 8; *(u32x2*)vd_ = (u32x2){v##S.x, v##S.y}; *(u32x2*)(vd_ + 16) = (u32x2){v##S.z, v##S.w}; } while (0)
    MLA_LOADK(t_lo, A); MLA_LOADK(t_lo + 1, B);
    const unsigned onew = q == 0 ? 0x3F803F80u : 0u;
    const bf16x8 vones = __builtin_bit_cast(bf16x8, (u32x4){onew, onew, onew, onew});
    bf16x8 qf[6]; float qn2 = 0.f;
    {
        float qv[6][8]; float ss = 0.f;
#pragma unroll
        for (int ks = 0; ks < 6; ++ks) { unpack8(*(const u32x4*)(QP + (size_t)qrow * 768 + h * 96 + 16 * ks + 8 * hf), qv[ks]);
#pragma unroll
            for (int j = 0; j < 8; ++j) ss += qv[ks][j] * qv[ks][j]; }
        ss += xor32(ss, hf);
        const float rs = (0.10206207261596577f * LOG2E) / sqrtf(ss * (1.0f / 96.0f) + EPSF);
#pragma unroll
        for (int ks = 0; ks < 6; ++ks) { const f32x4 g0 = *(const f32x4*)(gq + 16 * ks + 8 * hf), g1 = *(const f32x4*)(gq + 16 * ks + 8 * hf + 4);
#pragma unroll
            for (int j = 0; j < 4; ++j) { qv[ks][j] *= rs * g0[j]; qv[ks][4 + j] *= rs * g1[j]; } }
#pragma unroll
        for (int ks = 4; ks < 6; ++ks) { const float* rp = ropet + (size_t)(isctx ? 0 : qpos) * 32 + (ks - 4) * 8;
            const f32x4 c0 = *(const f32x4*)rp, c1 = *(const f32x4*)(rp + 4), n0_ = *(const f32x4*)(rp + 16), n1_ = *(const f32x4*)(rp + 20);
#pragma unroll
            for (int j = 0; j < 8; ++j) { const float pr = xor32(qv[ks][j], hf);
                if (!isctx) { const float c = j < 4 ? c0[j & 3] : c1[j & 3], sn = j < 4 ? n0_[j & 3] : n1_[j & 3]; qv[ks][j] = hf == 0 ? qv[ks][j] * c - pr * sn : qv[ks][j] * c + pr * sn; } } }
#pragma unroll
        for (int ks = 0; ks < 6; ++ks) qf[ks] = __builtin_bit_cast(bf16x8, pack8(qv[ks]));
#pragma unroll
        for (int ks = 0; ks < 6; ++ks)
#pragma unroll
            for (int j = 0; j < 8; ++j) qn2 += qv[ks][j] * qv[ks][j];
        qn2 += xor32(qn2, hf);
    }
    float gkm = fmaxf(fabsf(a.in[I_MGK][layer * 96 + (lane & 31)]), fmaxf(fabsf(a.in[I_MGK][layer * 96 + 32 + (lane & 31)]), fabsf(a.in[I_MGK][layer * 96 + 64 + (lane & 31)])));
    gkm = fmaxf(gkm, xpart<1>(gkm)); gkm = fmaxf(gkm, xpart<2>(gkm)); gkm = fmaxf(gkm, xpart<4>(gkm)); gkm = fmaxf(gkm, xpart<8>(gkm)); gkm = fmaxf(gkm, xpart<16>(gkm));
    const float mref = sqrtf(qn2) * gkm * (9.797958971132712f * 1.01f);
    f32x16 o0 = {}, o1 = {}, o2 = {};
    f32x16 negm;
#pragma unroll
    for (int r = 0; r < 16; ++r) negm[r] = -mref;
    asm volatile("" : "+v"(negm));
    u32x4 pp[4];
#pragma unroll
    for (int kk = 0; kk < 4; ++kk) pp[kk] = (u32x4){0u, 0u, 0u, 0u};
    MLA_STOREK(t_lo & 1, A); MLA_STOREK((t_lo + 1) & 1, B);
    MLA_LOADK(t_lo + 2, A); MLA_LOADV(t_lo, A);
    for (int i = tid; i < 64 * VSTR / 4; i += NTHREADS) ((unsigned*)(Vs + ((t_lo - 1) & 1) * VBUF))[i] = 0u;
    __syncthreads();
    f32x16 s0 = negm, s1 = negm;
    {   const unsigned char* kb_ = Ks + (t_lo & 1) * KBUF + q * KSTR + (8 * hf) * 2;
#pragma unroll
        for (int ks = 0; ks < 6; ++ks) { s0 = __builtin_amdgcn_mfma_f32_32x32x16_bf16(*(const bf16x8*)(kb_ + 32 * ks), qf[ks], s0, 0, 0, 0);
            s1 = __builtin_amdgcn_mfma_f32_32x32x16_bf16(*(const bf16x8*)(kb_ + 32 * KSTR + 32 * ks), qf[ks], s1, 0, 0, 0); } }
    __syncthreads();
#define NFR 6
#define DPF 5
#define MLA_LD(n_) do { if ((n_) < 8) fr[(n_) % NFR] = *(const bf16x8*)(vb_ + 32 * ((n_) & 1) * VSTR + 32 * ((n_) >> 1)); \
        else if ((n_) < 20) fr[(n_) % NFR] = *(const bf16x8*)(kb_ + 32 * (((n_) - 8) & 1) * KSTR + 32 * (((n_) - 8) >> 1)); } while (0)
#define MLA_CONS(i_) ((i_) < 12 ? ((i_) % 3 < 2 ? 2 * ((i_) / 3) + (i_) % 3 : -1) : (i_) - 4)
#define MLA_SV(e_) ((e_) < 16 ? s0[(e_) & 15] : s1[(e_) & 15])
#define MLA_MFMA(i_) do { const int n_ = MLA_CONS(i_), sl_ = (n_ < 0 ? 0 : n_) % NFR; \
            if ((i_) < 12) { const bf16x8 pf = __builtin_bit_cast(bf16x8, pp[(i_) / 3]); \
                if ((i_) % 3 == 0) o0 = __builtin_amdgcn_mfma_f32_32x32x16_bf16(fr[sl_], pf, o0, 0, 0, 0); \
                else if ((i_) % 3 == 1) o1 = __builtin_amdgcn_mfma_f32_32x32x16_bf16(fr[sl_], pf, o1, 0, 0, 0); \
                else o2 = __builtin_amdgcn_mfma_f32_32x32x16_bf16(vones, pf, o2, 0, 0, 0); } \
            else { const int j_ = (i_) - 12; \
                if (j_ == 0) n0 = __builtin_amdgcn_mfma_f32_32x32x16_bf16(fr[sl_], qf[0], negm, 0, 0, 0); \
                else if (j_ == 1) n1 = __builtin_amdgcn_mfma_f32_32x32x16_bf16(fr[sl_], qf[0], negm, 0, 0, 0); \
                else if ((j_ & 1) == 0) n0 = __builtin_amdgcn_mfma_f32_32x32x16_bf16(fr[sl_], qf[j_ >> 1], n0, 0, 0, 0); \
                else n1 = __builtin_amdgcn_mfma_f32_32x32x16_bf16(fr[sl_], qf[j_ >> 1], n1, 0, 0, 0); \
                if ((PROBE_MASK >> 19) & 1) { dmy = __builtin_amdgcn_mfma_f32_32x32x16_bf16(fr[sl_], qf[j_ >> 1], dmy, 0, 0, 0); } } \
            if (n_ >= 0) MLA_LD(n_ + DPF); } while (0)
#define MLA_ITER(t_, SN, SO) do { \
        MLA_STOREK((t_) & 1, SO); MLA_STOREV((t_) & 1, SO);            \
        MLA_LOADK((t_) + 3, SN); MLA_LOADV((t_) + 1, SN); \
        const unsigned char* vb_ = Vs + (((t_) - 1) & 1) * VBUF + q * VSTR + 16 * hf; \
        const unsigned char* kb_ = Ks + (((t_) + 1) & 1) * KBUF + q * KSTR + (8 * hf) * 2; \
        f32x16 n0, n1; f32x16 dmy = {}; \
          \
        _Pragma("unroll") for (int i = 0; i < 24; ++i) { MLA_MFMA(i); \
            { const int ne = i < 8 ? 2 : 1, e0 = i < 8 ? 2 * i : 8 + i; \
              _Pragma("unroll") for (int e2 = 0; e2 < ne; ++e2) { const int ee = e0 + e2; float pv = __builtin_amdgcn_exp2f(MLA_SV(ee)); asm volatile("" : "+v"(pv));     \
                if (ee < 16) s0[ee & 15] = pv; else s1[ee & 15] = pv; } } \
            { const int w = (i >= 3 && i <= 13) ? i - 3 : ((i >= 15 && (i & 1)) ? (i + 7) / 2 : -1); \
              if (w >= 0) { const int wc_ = w < 0 ? 0 : w; unsigned pw = pk2(MLA_SV(2 * wc_), MLA_SV(2 * wc_ + 1)); asm volatile("" : "+v"(pw)); \
                if ((wc_ & 3) == 0) pp[wc_ >> 2].x = pw; else if ((wc_ & 3) == 1) pp[wc_ >> 2].y = pw; else if ((wc_ & 3) == 2) pp[wc_ >> 2].z = pw; else pp[wc_ >> 2].w = pw; } } \
            __builtin_amdgcn_sched_barrier(0); \
            if (i == 19) { asm volatile("s_barrier" ::: "memory"); __builtin_amdgcn_sched_barrier(0); }     \
        } \
        { const unsigned char* vb_ = Vs + ((t_) & 1) * VBUF + q * VSTR + 16 * hf; MLA_LD(0); MLA_LD(1); MLA_LD(2); MLA_LD(3); MLA_LD(4); }     \
        asm volatile("s_barrier" ::: "memory");                        \
        if ((PROBE_MASK >> 19) & 1) asm volatile("" :: "v"(dmy)); \
        s0 = n0; s1 = n1; } while (0)
    bf16x8 fr[NFR];
    { const unsigned char* vb_ = Vs + ((t_lo - 1) & 1) * VBUF + q * VSTR + 16 * hf; const unsigned char* kb_ = Ks; MLA_LD(0); MLA_LD(1); MLA_LD(2); MLA_LD(3); MLA_LD(4); }
    for (int t = t_lo; t < t_hi; t += 2) { MLA_ITER(t, B, A); MLA_ITER(t + 1, A, B); }
#undef MLA_ITER
#undef MLA_LD
#undef MLA_CONS
#undef MLA_SV
#undef MLA_MFMA
    {
        const unsigned char* vb_ = Vs + ((t_hi - 1) & 1) * VBUF + q * VSTR + 16 * hf;
#pragma unroll
        for (int kk = 0; kk < 4; ++kk) { const bf16x8 pf = __builtin_bit_cast(bf16x8, pp[kk]);
            const bf16x8 v0 = *(const bf16x8*)(vb_ + 32 * kk), v1 = *(const bf16x8*)(vb_ + 32 * VSTR + 32 * kk);
            o0 = __builtin_amdgcn_mfma_f32_32x32x16_bf16(v0, pf, o0, 0, 0, 0); o1 = __builtin_amdgcn_mfma_f32_32x32x16_bf16(v1, pf, o1, 0, 0, 0);
            o2 = __builtin_amdgcn_mfma_f32_32x32x16_bf16(vones, pf, o2, 0, 0, 0); }
    }
    __syncthreads();
#undef MLA_LOADK
#undef MLA_LOADV
#undef MLA_STOREK
#undef MLA_STOREV
    const float l = o2[0] + xor32(o2[0], hf);
    const float il = 1.0f / l;
    bf16_t* dst = MIX + (size_t)qrow * DM + 512 + h * 64;
#pragma unroll
    for (int g4 = 0; g4 < 4; ++g4) {
        u32x2 w0, w1;
        w0.x = pk2(o0[4 * g4] * il, o0[4 * g4 + 1] * il); w0.y = pk2(o0[4 * g4 + 2] * il, o0[4 * g4 + 3] * il);
        w1.x = pk2(o1[4 * g4] * il, o1[4 * g4 + 1] * il); w1.y = pk2(o1[4 * g4 + 2] * il, o1[4 * g4 + 3] * il);
        *(u32x2*)(dst + 8 * g4 + 4 * hf) = w0; *(u32x2*)(dst + 32 + 8 * g4 + 4 * hf) = w1;
    }
}

__device__ __forceinline__ void kfin_phase(const Args& a) {
    const int tid = ltid(a), part = tid & 15, vl = tid >> 4;
    unsigned char* A = a.ws + WS_A;
    const bf16_t* KN = (const bf16_t*)(A + A_KN); const bf16_t* KR = (const bf16_t*)(A + A_KR); bf16_t* MK = (bf16_t*)(A + A_MK);
    const float* knss = (const float*)(a.ws + WS_KNSS); const float* krss = (const float*)(a.ws + WS_KRSS);
    if (part >= 12) return;
    for (int v = blockIdx.x * 32 + vl; v < NTOK * 8; v += gridDim.x * 32) {
        const int row = v >> 3, h = v & 7; int bb, tok; row_bt(row, bb, tok);
        const float rs = __builtin_amdgcn_rsqf((knss[v] + krss[row]) * (1.0f / 96.0f) + EPSF);
        float x[8]; unpack8(part < 8 ? *(const u32x4*)(KN + (size_t)row * 512 + h * 64 + part * 8) : *(const u32x4*)(KR + (size_t)row * 32 + (part - 8) * 8), x);
#pragma unroll
        for (int j = 0; j < 8; ++j) x[j] *= rs;
        *(u32x4*)(MK + ((size_t)(bb * 8 + h) * TOKB + tok) * 96 + part * 8) = pack8(x);
    }
}

__device__ __forceinline__ void na_block(const Args& a, int layer, bool isctx, int u, unsigned char* lds_g) {
    const int tid = ltid(a), lane = tid & 63, wave = __builtin_amdgcn_readfirstlane(tid >> 6), qi = lane & 15, g = lane >> 4;
    int b, h, r0 = 0, half = 0;
    if (isctx) { half = u & 1; h = (u >> 1) & 3; b = u >> 3; } else { r0 = 2 * (u & 15); h = (u >> 4) & 3; b = u >> 6; }
    const int r = r0 + (wave >> 2), j = wave & 3;
    unsigned char* A = a.ws + WS_A;
    const bf16_t* Qb = (const bf16_t*)(A + A_NAQ) + (size_t)(b * 4 + h) * TOKB * 64;
    const bf16_t* Kb = (const bf16_t*)(A + A_NAK) + (size_t)(b * 4 + h) * TOKB * 64;
    const bf16_t* VTb = (const bf16_t*)(A + A_NAVT) + (size_t)(b * 4 + h) * 64 * TOKB;
    bf16_t* MIX = (bf16_t*)(a.ws + WS_A + A_MIX);
    constexpr int KSTR = 144, VSTR = 528, KBUF = 256 * KSTR, VBUF = 64 * VSTR, BUF = KBUF + VBUF;
    static_assert(2 * BUF + 2048 <= LDS_BYTES - 64, "NA LDS");
    float* rpbs = (float*)(lds_g + 2 * BUF);
    if (!isctx) { const float* rpb = a.in[I_RPB] + (size_t)(layer * 4 + h) * 15 * 31; for (int i = tid; i < 465; i += NTHREADS) rpbs[i] = rpb[i] * LOG2E; }
    const int c = 16 * j + qi;
    const int qtok = isctx ? SEQ + half * 128 + wave * 16 + qi : r * 64 + c;
    const int rs = min(max(r - 4, 0), 24), bstart = min(max(16 * j - 8, 0), 32), cs = min(max(c - 8, 0), 48), u0 = min(max(r0 - 4, 0), 24);
    bf16x8 qf[2];
#pragma unroll
    for (int ks = 0; ks < 2; ++ks) qf[ks] = *(const bf16x8*)(Qb + (size_t)qtok * 64 + 32 * ks + 8 * g);
    float nr;
    { float qn2 = 0.f;
#pragma unroll
        for (int ks = 0; ks < 2; ++ks) { float x[8]; unpack8(__builtin_bit_cast(u32x4, qf[ks]), x);
#pragma unroll
            for (int jj = 0; jj < 8; ++jj) qn2 += x[jj] * x[jj]; }
        qn2 += xpart<16>(qn2); qn2 = xsum32(qn2);
        float gkm = fabsf(a.in[I_NAGK][layer * 64 + lane]);
        gkm = fmaxf(gkm, xpart<1>(gkm)); gkm = fmaxf(gkm, xpart<2>(gkm)); gkm = fmaxf(gkm, xpart<4>(gkm)); gkm = fmaxf(gkm, xpart<8>(gkm)); gkm = fmaxf(gkm, xpart<16>(gkm)); gkm = xmax32(gkm);
        nr = -sqrtf(qn2) * gkm * (8.0f * 1.01f); }
    const int dc0 = bstart + 4 * g - c + 15; unsigned vmask = 0u;
#pragma unroll
    for (int tt = 0; tt < 2; ++tt)
#pragma unroll
        for (int reg = 0; reg < 4; ++reg) { const int kc = bstart + 16 * tt + 4 * g + reg; vmask |= (kc >= cs && kc < cs + 16) ? (1u << (4 * tt + reg)) : 0u; }
    f32x4 o[4];
#pragma unroll
    for (int dt = 0; dt < 4; ++dt) o[dt] = (f32x4){0.f, 0.f, 0.f, 0.f};
    float l = 0.f;
    const int nseg = isctx ? 1 : 4;
    u32x4 kr[4][4], vr[4][4];
#define NAB_TOK(sg) ((sg) == 0 ? SEQ : (u0 + 4 * ((sg) - 1)) * 64)
#define NAB_LOAD(sg) do { const int tk = NAB_TOK(sg); _Pragma("unroll") for (int i = 0; i < 4; ++i) { const int ck = tid + NTHREADS * i; \
        kr[sg][i] = *(const u32x4*)(Kb + (size_t)tk * 64 + ck * 8); vr[sg][i] = *(const u32x4*)(VTb + (size_t)(ck >> 5) * TOKB + tk + (ck & 31) * 8); } } while (0)
#define NAB_STORE(bf, sg) do { unsigned char* kd = lds_g + (bf) * BUF; unsigned char* vd = kd + KBUF; _Pragma("unroll") for (int i = 0; i < 4; ++i) { const int ck = tid + NTHREADS * i; \
        *(u32x4*)(kd + (ck >> 3) * KSTR + (ck & 7) * 16) = kr[sg][i]; *(u32x4*)(vd + (ck >> 5) * VSTR + (ck & 31) * 16) = vr[sg][i]; } } while (0)
    NAB_LOAD(0); if (!isctx) { NAB_LOAD(1); NAB_LOAD(2); NAB_LOAD(3); }
    NAB_STORE(0, 0);
    __syncthreads();
#pragma unroll
    for (int sg = 0; sg < 4; ++sg) { if (sg < nseg) {
        const unsigned char* kb_ = lds_g + (sg & 1) * BUF; const unsigned char* vb_ = kb_ + KBUF;
        const int nchk = sg == 0 ? 4 : 2;
#pragma unroll 1
        for (int ch = 0; ch < nchk; ++ch) {
            int lt0, lt1, wi0 = 0, wi1 = 0; bool in0 = true, in1 = true;
            if (sg == 0) { lt0 = 64 * ch; lt1 = lt0 + 32; }
            else { const int R0 = u0 + 4 * (sg - 1) + 2 * ch; wi0 = R0 - rs; wi1 = wi0 + 1; in0 = wi0 >= 0 && wi0 < 8; in1 = wi1 >= 0 && wi1 < 8; lt0 = 128 * ch + bstart; lt1 = lt0 + 64; }
            if (!in0 && !in1) continue;
            f32x4 s[2][2];
#pragma unroll
            for (int g4 = 0; g4 < 2; ++g4) { const int lt = g4 ? lt1 : lt0;
#pragma unroll
                for (int tt = 0; tt < 2; ++tt) { s[g4][tt] = (f32x4){nr, nr, nr, nr};
#pragma unroll
                    for (int ks = 0; ks < 2; ++ks) { const bf16x8 kf = *(const bf16x8*)(kb_ + (lt + 16 * tt + qi) * KSTR + (32 * ks + 8 * g) * 2);
                        s[g4][tt] = __builtin_amdgcn_mfma_f32_16x16x32_bf16(kf, qf[ks], s[g4][tt], 0, 0, 0); } } }
            if (sg > 0) {
#pragma unroll
                for (int g4 = 0; g4 < 2; ++g4) { const int wi = g4 ? wi1 : wi0; const bool inw = g4 ? in1 : in0; const int dr = min(max(rs + wi - r + 7, 0), 14);
#pragma unroll
                    for (int tt = 0; tt < 2; ++tt)
#pragma unroll
                        for (int reg = 0; reg < 4; ++reg) { const float bias = rpbs[dr * 31 + min(max(dc0 + 16 * tt + reg, 0), 30)]; s[g4][tt][reg] = (inw && ((vmask >> (4 * tt + reg)) & 1u)) ? s[g4][tt][reg] + bias : -1e30f; } }
            }
            float ps = 0.f;
#pragma unroll
            for (int g4 = 0; g4 < 2; ++g4)
#pragma unroll
                for (int tt = 0; tt < 2; ++tt)
#pragma unroll
                    for (int reg = 0; reg < 4; ++reg) { const float pv = __builtin_amdgcn_exp2f(s[g4][tt][reg]); s[g4][tt][reg] = pv; ps += pv; }
            l += ps;
#pragma unroll
            for (int g4 = 0; g4 < 2; ++g4) { const int lt = g4 ? lt1 : lt0;
                u32x4 pw; pw.x = pk2(s[g4][0][0], s[g4][0][1]); pw.y = pk2(s[g4][0][2], s[g4][0][3]); pw.z = pk2(s[g4][1][0], s[g4][1][1]); pw.w = pk2(s[g4][1][2], s[g4][1][3]);
                const bf16x8 pf = __builtin_bit_cast(bf16x8, pw);
#pragma unroll
                for (int dt = 0; dt < 4; ++dt) { const unsigned char* vp = vb_ + (16 * dt + qi) * VSTR + (lt + 4 * g) * 2;
                    const u32x2 lo = *(const u32x2*)vp, hi = *(const u32x2*)(vp + 32);
                    u32x4 w; w.x = lo.x; w.y = lo.y; w.z = hi.x; w.w = hi.y;
                    o[dt] = __builtin_amdgcn_mfma_f32_16x16x32_bf16(__builtin_bit_cast(bf16x8, w), pf, o[dt], 0, 0, 0); }
            }
        }
        if (sg + 1 < nseg) NAB_STORE((sg + 1) & 1, (sg + 1 < 4 ? sg + 1 : 3));
        __syncthreads();
    } }
#undef NAB_TOK
#undef NAB_LOAD
#undef NAB_STORE
    l += xpart<16>(l); l = xsum32(l);
    const float il = 1.0f / l;
    const int orow = isctx ? NLAT + b * CTXL + half * 128 + wave * 16 + qi : b * SEQ + qtok;
    bf16_t* dst = MIX + (size_t)orow * DM + 256 + h * 64 + 4 * g;
#pragma unroll
    for (int dt = 0; dt < 4; ++dt) { u32x2 w; w.x = pk2(o[dt][0] * il, o[dt][1] * il); w.y = pk2(o[dt][2] * il, o[dt][3] * il); *(u32x2*)(dst + 16 * dt) = w; }
}

template <int L>
__device__ __forceinline__ void hyena_unit(const Args& a, int layer, int c, unsigned char* lds_g) {
    constexpr bool ISC = (L == CTXL);
    constexpr int NBLK = L / 32, NTILE = NBLK / 4, GLEN = 2 * L + 256, GST = GLEN + 32, ULEN = L + 200;
    constexpr int OFF_G = 0, OFF_U = OFF_G + 4 * GST * 2, OFF_X1 = OFF_U + 8 * ULEN * 2, OFF_X2 = OFF_X1 + 8 * L * 2, OFF_RED = OFF_X2 + 8 * L * 2, OFF_W3 = OFF_RED + 256;
    static_assert(OFF_W3 + 1024 + 64 <= LDS_BYTES, "hyena LDS");
    const int tid = ltid(a), lane = tid & 63, wave = __builtin_amdgcn_readfirstlane(tid >> 6);
    bf16_t* G = (bf16_t*)(lds_g + OFF_G); bf16_t* U = (bf16_t*)(lds_g + OFF_U); bf16_t* X1 = (bf16_t*)(lds_g + OFF_X1); bf16_t* X2 = (bf16_t*)(lds_g + OFF_X2);
    float* TMP = (float*)(lds_g + OFF_X1);
    float* RED = (float*)(lds_g + OFF_RED);
    static_assert(4 * L * 4 <= 2 * 8 * L * 2, "TMP fits");
    const bf16_t* PT = (const bf16_t*)(a.ws + WS_A + A_PT); bf16_t* OHYT = (bf16_t*)(a.ws + WS_A + A_OHYT);
    const int rowbase = ISC ? NLAT : 0;
    constexpr int NIT = L >= NTHREADS ? L / NTHREADS : 1;
    const bf16_t* ktap = (const bf16_t*)(a.ws + WS_KTAP) + ((size_t)layer * 1024 + c) * TOKB + (ISC ? SEQ : 0);
    unsigned tp[NIT][2];
#pragma unroll
    for (int it = 0; it < NIT; ++it) { const int l = tid + NTHREADS * it; tp[it][0] = 0u; tp[it][1] = 0u;
        if (l < L) { tp[it][0] = (unsigned)ktap[l] | ((unsigned)ktap[(size_t)256 * TOKB + l] << 16); tp[it][1] = (unsigned)ktap[(size_t)512 * TOKB + l] | ((unsigned)ktap[(size_t)768 * TOKB + l] << 16); } }
    u32x4 pw[3][NIT]; unsigned pe[3][NIT];
#define HY_PREF(CH0_, CH1_) _Pragma("unroll") \
    for (int ch = CH0_; ch < CH1_; ++ch) { \
        const bf16_t* src = PT + (size_t)(ch * 256 + c) * NTOK + rowbase; \
        _Pragma("unroll") \
        for (int i = 0; i < NIT; ++i) { \
            const int qd = tid + NTHREADS * i; \
            pw[ch][i] = (u32x4){0u, 0u, 0u, 0u}; pe[ch][i] = 0u; \
            if (qd < L) { const int b = qd / (L / 8), t0 = (qd % (L / 8)) * 8; const bf16_t* sp = src + b * L + t0; \
                pw[ch][i] = *(const u32x4*)sp; \
                const unsigned el = t0 > 0 ? (unsigned)sp[-1] : 0u, er = t0 + 8 < L ? (unsigned)sp[8] : 0u; \
                pe[ch][i] = el | (er << 16); } \
        } \
    }
    HY_PREF(0, 2)
#if 0
    for (int ch = 0; ch < 3; ++ch) {
        const bf16_t* src = PT + (size_t)(ch * 256 + c) * NTOK + rowbase;
#pragma unroll
        for (int i = 0; i < NIT; ++i) {
            const int qd = tid + NTHREADS * i;
            pw[ch][i] = (u32x4){0u, 0u, 0u, 0u}; pe[ch][i] = 0u;
            if (qd < L) { const int b = qd / (L / 8), t0 = (qd % (L / 8)) * 8; const bf16_t* sp = src + b * L + t0;
                pw[ch][i] = *(const u32x4*)sp;
                const unsigned el = t0 > 0 ? (unsigned)sp[-1] : 0u, er = t0 + 8 < L ? (unsigned)sp[8] : 0u;
                pe[ch][i] = el | (er << 16); }
        }
    }
#endif
    {
        float as0 = 0.f, as1 = 0.f;
#pragma unroll
        for (int it = 0; it < NIT; ++it) { const int l = tid + NTHREADS * it;
            if (l < L) { const float k0 = bflo(tp[it][0]), k1 = bfhi(tp[it][0]), k2 = bflo(tp[it][1]), k3 = bfhi(tp[it][1]);
                TMP[0 * L + l] = k0; TMP[1 * L + l] = k1; TMP[2 * L + l] = k2; TMP[3 * L + l] = k3;
                as0 += fabsf(k0) + fabsf(k1); as1 += fabsf(k2) + fabsf(k3); } }
        HY_PREF(2, 3)
#undef HY_PREF
        as0 = wave_sum(as0); as1 = wave_sum(as1);
        if (lane == 0) { RED[wave * 2] = as0; RED[wave * 2 + 1] = as1; }
        __syncthreads();
        float t0 = 0.f, t1 = 0.f;
#pragma unroll
        for (int w = 0; w < 8; ++w) { t0 += RED[w * 2]; t1 += RED[w * 2 + 1]; }
        const float inv0 = 1.0f / (t0 + EPSF), inv1 = 1.0f / (t1 + EPSF);
#pragma unroll 1
        for (int rp = 0; rp < 1 + (ISC ? 0 : ((PROBE_MASK >> 23) & 1)); ++rp)
        for (int i = tid; i < 4 * GST; i += NTHREADS) {
            if (rp) asm volatile("" ::: "memory");
            const int o = i / (2 * GST), cp = (i / GST) & 1, idx = i % GST;
            const int jj = L - (idx - 128 + cp);
            float v = 0.f;
            if (jj >= 0 && jj <= L - 1) v = TMP[(o * 2 + 0) * L + jj]; else if (jj < 0 && -jj <= L - 1) v = TMP[(o * 2 + 1) * L - jj];
            G[i] = (bf16_t)f2bf(v * (o ? inv1 : inv0));
        }
        __syncthreads();
    }
#pragma unroll 1
    for (int rp = 0; rp < 1 + (ISC ? 0 : ((PROBE_MASK >> 24) & 1)); ++rp)
#pragma unroll
    for (int ch = 0; ch < 3; ++ch) {
        if (rp) asm volatile("" ::: "memory");
        const int col = ch * 256 + c;
        const float w0 = a.in[I_HCW][((size_t)layer * 3 + 0) * 768 + col], w1 = a.in[I_HCW][((size_t)layer * 3 + 1) * 768 + col], w2 = a.in[I_HCW][((size_t)layer * 3 + 2) * 768 + col];
        const float cb = a.in[I_HCB][layer * 768 + col];
#pragma unroll
        for (int i = 0; i < NIT; ++i) {
            const int qd = tid + NTHREADS * i;
            if (qd < L) {
                const int b = qd / (L / 8), t0 = (qd % (L / 8)) * 8;
                const u32x4 w = pw[ch][i];
                float u[10];
                u[0] = bflo(pe[ch][i]); u[9] = bfhi(pe[ch][i]);
                u[1] = bflo(w.x); u[2] = bfhi(w.x); u[3] = bflo(w.y); u[4] = bfhi(w.y); u[5] = bflo(w.z); u[6] = bfhi(w.z); u[7] = bflo(w.w); u[8] = bfhi(w.w);
                float y[8];
#pragma unroll
                for (int k = 0; k < 8; ++k) y[k] = w0 * u[k] + w1 * u[k + 1] + w2 * u[k + 2] + cb;
                u32x4 o; o.x = pk2(y[0], y[1]); o.y = pk2(y[2], y[3]); o.z = pk2(y[4], y[5]); o.w = pk2(y[6], y[7]);
                bf16_t* dp = ch == 0 ? U + b * ULEN + 96 + t0 : (ch == 1 ? X1 + b * L + t0 : X2 + b * L + t0);
                *(u32x4*)dp = o;
            }
        }
    }
    for (int i = tid; i < 8 * 96; i += NTHREADS) { const int b = i / 96, k = i % 96; *(unsigned*)(U + b * ULEN + 2 * (k % 48) + (k >= 48 ? 96 + L : 0)) = 0u; }
    __syncthreads();
    const int n = lane & 31, hf = lane >> 5, il = n & 3, bb = n >> 2, ti = n;
    const float hb0 = a.in[I_HBIAS][(layer * 2 + 0) * 256 + c], hb1 = a.in[I_HBIAS][(layer * 2 + 1) * 256 + c];
    const int tau0 = 2 * wave, tau1 = 2 * wave + 1;
    const bool act0 = tau0 < NTILE, act1 = tau1 < NTILE;
#pragma unroll 1
    for (int o = 0; o < 2; ++o) {
        f32x16 acc0 = {}, acc1 = {};
        if constexpr (!ISC) {
            const int dlo = 4 * tau0 - (NBLK - 1);
            const bf16_t* ga = G + (o * 2 + (ti & 1)) * GST + (128 + L - ti + 8 * hf - (ti & 1)) - 32 * dlo;
            const bf16_t* ub = U + bb * ULEN + 96 + 32 * ((NBLK - 1) + il) + 8 * hf;
#define HY_LDA(e_, ks_) ({ const unsigned* gp_ = (const unsigned*)(ga - 32 * (e_) + 16 * (ks_)); u32x4 aw_; aw_.x = gp_[0]; aw_.y = gp_[1]; aw_.z = gp_[2]; aw_.w = gp_[3]; __builtin_bit_cast(bf16x8, aw_); })
#define HY_LDB(e_, ks_) (*(const bf16x8*)(ub - 32 * (e_) + 16 * (ks_)))
            bf16x8 rg[4][2];
#pragma unroll 1
            for (int rp = 0; rp < 1 + ((PROBE_MASK >> 21) & 1); ++rp) {
            if (rp) { float zf = 0.f; asm volatile("" : "+v"(zf)); acc0 *= zf; acc1 *= zf; }
            bf16x8 ca0 = HY_LDA(0, 0), ca1 = HY_LDA(0, 1), cb0 = HY_LDB(0, 0), cb1 = HY_LDB(0, 1);
#define HY_STEP(e_, j_, T0_, T1_, NA_, NB_) { \
                bf16x8 na0 = ca0, na1 = ca1, nb0 = cb0, nb1 = cb1; \
                if (NA_) { na0 = HY_LDA((e_) + 1, 0); na1 = HY_LDA((e_) + 1, 1); } \
                if (NB_) { nb0 = HY_LDB((e_) + 1, 0); nb1 = HY_LDB((e_) + 1, 1); } \
                __builtin_amdgcn_sched_barrier(0); \
                if (T0_) acc0 = __builtin_amdgcn_mfma_f32_32x32x16_bf16(ca0, cb0, acc0, 0, 0, 0); \
                if (T1_) acc1 = __builtin_amdgcn_mfma_f32_32x32x16_bf16(ca0, rg[j_][0], acc1, 0, 0, 0); \
                if (T0_) acc0 = __builtin_amdgcn_mfma_f32_32x32x16_bf16(ca1, cb1, acc0, 0, 0, 0); \
                if (T1_) acc1 = __builtin_amdgcn_mfma_f32_32x32x16_bf16(ca1, rg[j_][1], acc1, 0, 0, 0); \
                if (T0_) { rg[j_][0] = cb0; rg[j_][1] = cb1; } \
                ca0 = na0; ca1 = na1; cb0 = nb0; cb1 = nb1; \
                __builtin_amdgcn_sched_barrier(0); }
#pragma unroll
            for (int j = 0; j < 4; ++j) HY_STEP(j, j, true, false, true, true)
#pragma unroll 1
            for (int g = 1; g < 16; ++g) {
#pragma unroll
                for (int j = 0; j < 4; ++j) HY_STEP(4 * g + j, j, true, true, true, true)
            }
            HY_STEP(64, 0, true, true, true, true)
            HY_STEP(65, 1, true, true, true, true)
            HY_STEP(66, 2, true, true, true, false)
            HY_STEP(67, 3, false, true, true, false)
            HY_STEP(68, 0, false, true, true, false)
            HY_STEP(69, 1, false, true, true, false)
            HY_STEP(70, 2, false, true, false, false)
#undef HY_STEP
            }
#undef HY_LDA
#undef HY_LDB
        } else if (act0) {
            const bf16_t* gb = G + (o * 2 + (ti & 1)) * GST + (128 + L - ti + 8 * hf - (ti & 1));
            const int dlo = 4 * tau0 - (NBLK - 1), dhi = (act1 ? 4 * tau1 : 4 * tau0) + 3;
            for (int d = dlo; d <= dhi; ++d) {
                const bool in0 = d <= 4 * tau0 + 3, in1 = act1 && d >= 4 * tau1 - (NBLK - 1);
#pragma unroll
                for (int ks = 0; ks < 2; ++ks) {
                    const unsigned* gp = (const unsigned*)(gb - 32 * d + 16 * ks);
                    u32x4 aw; aw.x = gp[0]; aw.y = gp[1]; aw.z = gp[2]; aw.w = gp[3];
                    const bf16x8 af = __builtin_bit_cast(bf16x8, aw);
                    if (in0) { const bf16x8 bf = *(const bf16x8*)(U + bb * ULEN + 96 + 32 * (4 * tau0 + il - d) + 16 * ks + 8 * hf);
                        acc0 = __builtin_amdgcn_mfma_f32_32x32x16_bf16(af, bf, acc0, 0, 0, 0); }
                    if (in1) { const bf16x8 bf = *(const bf16x8*)(U + bb * ULEN + 96 + 32 * (4 * tau1 + il - d) + 16 * ks + 8 * hf);
                        acc1 = __builtin_amdgcn_mfma_f32_32x32x16_bf16(af, bf, acc1, 0, 0, 0); }
                }
            }
        }
        const bf16_t* XG = o == 0 ? X1 : X2; const float hb = o == 0 ? hb0 : hb1;
        u32x2 z0[4], z1[4];
#pragma unroll
        for (int g4 = 0; g4 < 4; ++g4) {
            if (act0) { const int t = 32 * (4 * tau0 + il) + 8 * g4 + 4 * hf;
                const u32x2 uw = *(const u32x2*)(U + bb * ULEN + 96 + t), gw = *(const u32x2*)(XG + bb * L + t);
                const float y0 = bflo(gw.x) * (acc0[4 * g4] + hb * bflo(uw.x)), y1 = bfhi(gw.x) * (acc0[4 * g4 + 1] + hb * bfhi(uw.x));
                const float y2 = bflo(gw.y) * (acc0[4 * g4 + 2] + hb * bflo(uw.y)), y3 = bfhi(gw.y) * (acc0[4 * g4 + 3] + hb * bfhi(uw.y));
                z0[g4].x = pk2(y0, y1); z0[g4].y = pk2(y2, y3); }
            if (act1) { const int t = 32 * (4 * tau1 + il) + 8 * g4 + 4 * hf;
                const u32x2 uw = *(const u32x2*)(U + bb * ULEN + 96 + t), gw = *(const u32x2*)(XG + bb * L + t);
                const float y0 = bflo(gw.x) * (acc1[4 * g4] + hb * bflo(uw.x)), y1 = bfhi(gw.x) * (acc1[4 * g4 + 1] + hb * bfhi(uw.x));
                const float y2 = bflo(gw.y) * (acc1[4 * g4 + 2] + hb * bflo(uw.y)), y3 = bfhi(gw.y) * (acc1[4 * g4 + 3] + hb * bfhi(uw.y));
                z1[g4].x = pk2(y0, y1); z1[g4].y = pk2(y2, y3); }
        }
        __syncthreads();
        if (o == 0) {
#pragma unroll
            for (int g4 = 0; g4 < 4; ++g4) {
                if (act0) *(u32x2*)(U + bb * ULEN + 96 + 32 * (4 * tau0 + il) + 8 * g4 + 4 * hf) = z0[g4];
                if (act1) *(u32x2*)(U + bb * ULEN + 96 + 32 * (4 * tau1 + il) + 8 * g4 + 4 * hf) = z1[g4];
            }
            __syncthreads();
        } else {
            bf16_t* dst = OHYT + (size_t)c * NTOK + rowbase + bb * L;
#pragma unroll
            for (int g4 = 0; g4 < 4; ++g4) {
                if (act0) *(u32x2*)(dst + 32 * (4 * tau0 + il) + 8 * g4 + 4 * hf) = z0[g4];
                if (act1) *(u32x2*)(dst + 32 * (4 * tau1 + il) + 8 * g4 + 4 * hf) = z1[g4];
            }
        }
    }
    __syncthreads();
}

__device__ __forceinline__ void mixer_phase(const Args& a, int layer, unsigned char* lds_g) {
    const bool last = layer == DEPTH - 1;
    const int wave = ltid(a) >> 6;
    const int G = gridDim.x, bx = blockIdx.x;
#pragma unroll 1
    for (int rp = 0; rp < 1 + ((PROBE_MASK >> 12) & 1); ++rp)
#pragma unroll 1
    for (int it = bx; it < 256; it += G) hyena_unit<SEQ>(a, layer, it, lds_g);
#pragma unroll 1
    for (int rp = 0; rp < 1 + ((PROBE_MASK >> 13) & 1); ++rp)
#pragma unroll 1
    for (int it = bx; it < (last ? 512 : 576); it += G) {
        if (it < 512) { int bh = it >> 3, qb = it & 7;
            if (G == 256) { const int rr = it >> 8, x = bx & 7, sl = bx >> 3; bh = 32 * rr + (sl >> 3) * 8 + x; qb = sl & 7; }
            mla_unit(a, layer, bh >> 3, bh & 7, qb, lds_g); }
        else { const int u = it - 512; mla_unit(a, layer, u >> 3, u & 7, 8, lds_g); } }
#pragma unroll 1
    for (int rp = 0; rp < 1 + ((PROBE_MASK >> 14) & 1); ++rp)
#pragma unroll 1
    for (int it = bx; it < (last ? 512 : 576); it += G) {
        if (it < 512) { int u = it;
            if (G == 256) { const int rr = it >> 8, x = bx & 7, sl = bx >> 3; u = (16 * rr + (sl >> 4) * 8 + x) * 16 + (sl & 15); }
            na_block(a, layer, false, u, lds_g); }
        else if (G != 256) na_block(a, layer, true, it - 512, lds_g); }
    if (G == 256 && !last && bx >= 64 && bx < 128) {
#pragma unroll 1
        for (int rp = 0; rp < 1 + ((PROBE_MASK >> 14) & 1); ++rp) na_block(a, layer, true, bx - 64, lds_g); }
    if (!last) {
#pragma unroll 1
    for (int rp = 0; rp < 1 + ((PROBE_MASK >> 15) & 1); ++rp)
#pragma unroll 1
        for (int it = bx; it < 256; it += G) hyena_unit<CTXL>(a, layer, it, lds_g);
    }
}
__device__ __forceinline__ void ohy_phase(const Args& a, int nrows, unsigned char* lds_g) {
    const bf16_t* OHYT = (const bf16_t*)(a.ws + WS_A + A_OHYT); bf16_t* MIX = (bf16_t*)(a.ws + WS_A + A_MIX);
    if (nrows == NTOK) {
        for (int item = blockIdx.x; item < NTOK / 72; item += gridDim.x)
            transpose_tile<256, 72>(a, OHYT + item * 72, NTOK, MIX + (size_t)item * 72 * DM, DM, lds_g);
    } else
    for (int item = blockIdx.x; item < nrows / 64; item += gridDim.x)
        transpose_tile<256, 64>(a, OHYT + item * 64, NTOK, MIX + (size_t)item * 64 * DM, DM, lds_g);
}


#define GAS __attribute__((address_space(1)))
typedef GAS unsigned gu32;
#define XB_TMO      128
#define XB_XCNT(j)  (256  + 64 * (j))
#define XB_XSUB(j)  (1280 + 64 * (j))
#define XB_XGEN(j)  (2304 + 64 * (j))
#define XB_TOP      3328
#define XB_TOPGEN   3392
#define XCD_BAR_WORDS 3456
#define XB_SPIN_CAP (1u << 18)

__device__ __forceinline__ unsigned xb_ld(unsigned* p)              { return __hip_atomic_load(p, __ATOMIC_RELAXED, __HIP_MEMORY_SCOPE_AGENT); }
__device__ __forceinline__ unsigned xb_add(unsigned* p, unsigned v) { return __hip_atomic_fetch_add(p, v, __ATOMIC_RELAXED, __HIP_MEMORY_SCOPE_AGENT); }
__device__ __forceinline__ unsigned xb_xcc_id() { return (unsigned)__builtin_amdgcn_s_getreg((3 << 11) | 20) & 0xFu; }
#define XB_SPIN(cond, bar) do { unsigned _sp = 0; while (cond) { __builtin_amdgcn_s_sleep(1); \
    if ((++_sp & 255u) == 0u) { if (xb_ld(&(bar)[XB_TMO])) break; if (_sp > XB_SPIN_CAP) { atomicAdd(&(bar)[XB_TMO], 1u); break; } } } } while (0)

struct XcdBarrier {
    unsigned* bar; unsigned x;
    volatile LAS unsigned* st;
};

__device__ __forceinline__ XcdBarrier xcd_barrier_post(unsigned* bar, volatile LAS unsigned* st, bool leader) {
    XcdBarrier b; b.bar = bar; b.x = xb_xcc_id(); b.st = st;
    if (leader) (void)xb_add(&bar[XB_XCNT(b.x)], 1u);
    return b;
}
__device__ __forceinline__ void xcd_barrier_complete(unsigned* bar, unsigned x, unsigned& nloc, unsigned& nx) {
    const unsigned G = gridDim.x * gridDim.y * gridDim.z;
    unsigned sum, cnt, mine, sp = 0u;
    for (;;) {
        sum = 0u; cnt = 0u; mine = 0u;
#pragma unroll
        for (unsigned j = 0; j < 16; ++j) { const unsigned c = xb_ld(&bar[XB_XCNT(j)]); sum += c; cnt += (c > 0u) ? 1u : 0u; mine = (j == x) ? c : mine; }
        if (sum == G) break;
        __builtin_amdgcn_s_sleep(1);
        if ((++sp & 255u) == 0u) { if (xb_ld(&bar[XB_TMO])) break; if (sp > XB_SPIN_CAP) { atomicAdd(&bar[XB_TMO], 1u); break; } }
    }
    nloc = mine > 0u ? mine : 1u; nx = cnt > 0u ? cnt : 1u;
}

__device__ __forceinline__ void xcd_barrier(const XcdBarrier& b, bool leader) {
    asm volatile("s_waitcnt vmcnt(0)" ::: "memory");
    __syncthreads();
    if (leader) {
        unsigned* bar = b.bar;
        __builtin_amdgcn_s_waitcnt(0);
        unsigned nloc = b.st[0], nx = b.st[1];
        if (nloc == 0u) { xcd_barrier_complete(bar, b.x, nloc, nx); b.st[0] = nloc; b.st[1] = nx; }
        const unsigned old = xb_add(&bar[XB_XSUB(b.x)], 1u);
        const unsigned gen = old / nloc;
        if (old + 1u == (gen + 1u) * nloc) {
            __builtin_amdgcn_fence(__ATOMIC_RELEASE, "agent");
            asm volatile("s_waitcnt vmcnt(0)" ::: "memory");
            const unsigned og = xb_add(&bar[XB_TOP], 1u);
            const unsigned tg = og / nx;
            if (og + 1u == (tg + 1u) * nx) xb_add(&bar[XB_TOPGEN], 1u);
            else XB_SPIN(xb_ld(&bar[XB_TOPGEN]) == tg, bar);
            __builtin_amdgcn_fence(__ATOMIC_ACQUIRE, "agent");
            xb_add(&bar[XB_XGEN(b.x)], 1u);
            asm volatile("s_waitcnt vmcnt(0)" ::: "memory");
        } else {
            XB_SPIN(xb_ld(&bar[XB_XGEN(b.x)]) == gen, bar);
            __builtin_amdgcn_fence(__ATOMIC_ACQUIRE, "agent");
            asm volatile("s_waitcnt vmcnt(0)" ::: "memory");
        }
    }
    __syncthreads();
}

constexpr int PH_PER_LAYER = 9, N_PHASES = 1 + DEPTH * PH_PER_LAYER;
template <bool SYNC>
__global__ void __launch_bounds__(NTHREADS, 2) fwd_kernel(Args a_) {
    extern __shared__ __attribute__((aligned(16))) unsigned char lds[];
    unsigned char* lds_g = lds;
    LAS unsigned char* lds3 = (LAS unsigned char*)lds;
    volatile LAS unsigned* bst = (volatile LAS unsigned*)(lds3 + LDS_BYTES - 64);
    XcdBarrier bar; bar.bar = nullptr; bar.x = 0; bar.st = nullptr;
    const int wv0 = __builtin_amdgcn_readfirstlane((int)(threadIdx.x >> 6));
#define LEADER_ (wv0 == 0 && lane_now() == 0)
    if (SYNC) { if (wv0 == 0 && lane_now() < 2) bst[lane_now()] = 0u; __syncthreads(); bar = xcd_barrier_post((unsigned*)a_.ws + 4096, bst, LEADER_); }
    for (int ph = a_.ph_lo; ph < a_.ph_hi; ++ph) {
      for (int rep = 0; rep < 2; ++rep) {
        if (rep == 1) { const int kq = (ph - 1) % PH_PER_LAYER, kk = ph == 0 ? 11 : (kq < 2 ? kq : (kq == 2 ? 3 : kq + 2)); if (!((PROBE_MASK >> kk) & 1)) break; __syncthreads(); if (SYNC) xcd_barrier(bar, LEADER_); }
        Args a = a_; a.wv = wv0;
        { size_t z = 0; asm volatile("" : "+s"(z)); a.ws = a_.ws + z; a.out = a_.out + z; }
        unsigned char* ws = a.ws;
        if (ph == 0) phase0(a, lds_g);
        else {
            const int layer = (ph - 1) / PH_PER_LAYER, kq = (ph - 1) % PH_PER_LAYER, k = kq < 2 ? kq : (kq == 2 ? 3 : kq + 2);
            const bool last = layer == DEPTH - 1;
            const int Mres = last ? NLAT : NTOK;
            unsigned char* wl = ws + WS_W + (size_t)layer * W_LAYER;
            unsigned char* A = ws + WS_A;
            const float* mod = (const float*)(ws + WS_MOD) + (size_t)layer * 9 * 6144;
            float* RSS1 = (float*)(ws + WS_RSS1); float* RSS2 = (float*)(ws + WS_RSS2);
            const unsigned oW = (unsigned)(WS_W + (size_t)layer * W_LAYER), oMOD = (unsigned)(WS_MOD + (size_t)layer * 9 * 6144 * 4), oA = (unsigned)WS_A;
            pg8::EpiX E; E.ws = ws; E.mode = 0; E.bias = nullptr; E.xlat = a.out; E.xdx = 0; E.o_gate = 0; E.o_part = 0; E.o_sw = 0; E.ldsw = 0; E.xgf = 0; E.gn = nullptr; E.o_gsc = 0; E.o_rssout = 0;
            E.o_cqss = (unsigned)WS_CQSS; E.o_ckvss = (unsigned)WS_CKVSS; E.gk = a.in[I_MGK] + layer * 96; E.knf = 0; E.nagq = a.in[I_NAGQ] + layer * 64; E.nagk = a.in[I_NAGK] + layer * 64;
            pg8::Sub sn; sn.A = 0; sn.Bt = 0; sn.M = 0; sn.N = 256; sn.kind = 0; sn.O = 0; sn.ldc = 0; sn.rss = 0; sn.rdiv = 0.f;
            pg8::Sub s0 = sn, s1 = sn, s2 = sn; int nsub = 0, Kdim = 0, ksplit = 1;
            switch (k) {
            case 0: if (layer == 0) { if (rep == 0) { tap_phase(a, lds_g); sw_phase(a, lds_g); } prenorm_pass(a, 0, 0, 0, NTOK, nullptr, 0, nullptr, nullptr, RSS1, RSS2, a.in[I_X], a.in[I_CTX], (rep == 0 && DEPTH * 24 < (int)gridDim.x) ? DEPTH * 24 : 0); }
                    else prenorm_pass(a, layer, 0, NLAT, NTOK, (const float*)(A + A_PART10), rep == 0 ? 8 : 0, mod - 9 * 6144 + 8 * 6144 + 5 * 1024, a.in[I_BFF2] + (layer - 1) * DM, RSS1, RSS2, a.out, (const float*)(ws + WS_XC));
                    break;
            case 1:
                    s0.A = oW + (unsigned)W_IN; s0.Bt = (unsigned)WS_XN; s0.M = 1024; s0.N = NTOK; s0.kind = 1;
                    s1.A = (unsigned)WS_XN; s1.Bt = oW + (unsigned)W_IN + 1024u * DM * 2u; s1.M = NTOK; s1.N = 1024; s1.kind = 2;
                    nsub = 2; Kdim = DM; E.o_sw = (unsigned)(WS_SW1 + (size_t)layer * 9 * 2048 * 4); E.ldsw = 2048;
                    if (rep) { E.o_cqss = (unsigned)WS_RSSDUMMY; E.o_ckvss = (unsigned)WS_RSSDUMMY; }
                    break;
            case 3:
                    s0.A = oA + (unsigned)A_CQ; s0.Bt = oW + (unsigned)W_Q; s0.M = NTOK; s0.N = 768; s0.O = oA + (unsigned)A_QP; s0.ldc = 768; s0.rss = (unsigned)WS_CQSS; s0.rdiv = 1.0f / 256.0f;
                    s1.A = oA + (unsigned)A_CKV; s1.Bt = oW + (unsigned)W_KV; s1.M = NTOK; s1.N = 512; s1.O = oA + (unsigned)A_KN; s1.ldc = 512; s1.rss = (unsigned)WS_CKVSS; s1.rdiv = 1.0f / 128.0f;
                    s2.A = oW + (unsigned)W_KV + 512u * 256u * 2u; s2.Bt = oA + (unsigned)A_CKV; s2.M = 512; s2.N = NTOK; s2.kind = 3;
                    nsub = 3; Kdim = 256; E.knf = 1; break;
            case 5: mixer_phase(a, layer, lds_g); break;
            case 6: ohy_phase(a, Mres, lds_g); break;
            case 7: if (layer == 0 && rep == 0) E.xdx = (long long)((const char*)a.in[I_X] - (const char*)a.out);
                    s0.A = oA + (unsigned)A_MIX; s0.Bt = oW + (unsigned)W_OUT; s0.M = Mres; s0.N = DM; nsub = 1; Kdim = DM; E.mode = 2; ksplit = 4; E.o_part = oA + (unsigned)A_PART7;
                    E.xgf = 1; E.gn = a.in[I_GN2] + layer * DM; E.o_gsc = oMOD + 4 * 1024 * 4; E.o_rssout = rep ? (unsigned)WS_RSSDUMMY : (unsigned)WS_RSS2;
                    E.o_gate = rep ? 256u * 1024u : oMOD + 2 * 1024 * 4; break;
            case 8: if (!last) prenorm_pass(a, layer, 1, NLAT, NTOK, (const float*)(A + A_PART7), rep == 0 ? 4 : 0, mod + 8 * 6144 + 2 * 1024, nullptr, RSS2, RSS1, a.out, layer == 0 ? a.in[I_CTX] : (const float*)(ws + WS_XC)); break;
            case 9: s0.A = (unsigned)WS_XN; s0.Bt = oW + (unsigned)W_FF1; s0.M = Mres; s0.N = DFF; s0.O = oA + (unsigned)A_H; s0.ldc = DFF; s0.rss = (unsigned)WS_RSS2; s0.rdiv = 1.0f / 1024.0f; nsub = 1; Kdim = DM; E.mode = 1;
                    E.o_sw = (unsigned)(WS_SW2 + (size_t)layer * 9 * 4096 * 4); E.ldsw = 4096; break;
            case 10: s0.A = oA + (unsigned)A_H; s0.Bt = oW + (unsigned)W_FF2; s0.M = Mres; s0.N = DM; nsub = 1; Kdim = DFF; E.mode = 2; ksplit = 8; E.o_part = oA + (unsigned)A_PART10;
                    E.o_gate = rep ? 256u * 1024u : oMOD + 5 * 1024 * 4; E.bias = a.in[I_BFF2] + layer * DM;
                    if (!last) { E.xgf = 1; E.gn = a.in[I_GN1] + (layer + 1) * DM; E.o_gsc = oMOD + (9 * 6144 + 1 * 1024) * 4; E.o_rssout = rep ? (unsigned)WS_RSSDUMMY : (unsigned)WS_RSS1; } break;
            }
            if (nsub > 0) {
                E.oO0 = s0.O; E.ldc0 = s0.ldc; E.orss0 = s0.rss; E.rdiv0 = s0.rdiv; E.oO1 = s1.O; E.ldc1 = s1.ldc; E.orss1 = s1.rss; E.rdiv1 = s1.rdiv;
                E.oO2 = s2.O; E.ldc2 = s2.ldc; E.orss2 = s2.rss; E.rdiv2 = s2.rdiv;
                pg8::Order S; S.init((const char*)ws, s0, s1, s2, nsub, Kdim, ksplit, gridDim.x, blockIdx.x);
                pg8::Gemm g{nullptr, nullptr, a.wv, 0, Kdim};
                pg8::gemm_phase<pg8::EpiX, pg8::Order, true, true>(lds3, g, S, E);
                if (k == 9 && rep == 0 && !last) {
                    const int nu = (Mres / 256) * 16, rem = nu % (int)gridDim.x;
                    wconv_layer(a, layer + 1, ((int)blockIdx.x - rem) * 8 + (int)(ltid(a) >> 6), ((int)gridDim.x - rem) * 8, lds_g);
                }
            }
        }
      }
        if (SYNC && ph + 1 < a_.ph_hi) { if (a_.ph_hi < 0) cg::this_grid().sync(); else xcd_barrier(bar, LEADER_); }
        else __syncthreads();
    }
}

extern "C" void kernel_launch(void* const* d_in, const int* in_sizes, int n_in, void* d_out, int out_size, void* d_ws, size_t ws_size, hipStream_t stream) {
    static int grid = 0;
    if (grid == 0) {
        if (n_in != 33 || out_size != NLAT * DM || ws_size < WS_END) { fprintf(stderr, "kernel_launch: unexpected shapes (n_in %d out %d ws %zu)\n", n_in, out_size, ws_size); grid = -1; return; }
        int dev = 0, cus = 0, per_cu = 0;
        (void)hipGetDevice(&dev); (void)hipDeviceGetAttribute(&cus, hipDeviceAttributeMultiprocessorCount, dev);
        (void)hipFuncSetAttribute((const void*)fwd_kernel<true>, hipFuncAttributeMaxDynamicSharedMemorySize, LDS_BYTES);
        if (hipOccupancyMaxActiveBlocksPerMultiprocessor(&per_cu, (const void*)fwd_kernel<true>, NTHREADS, LDS_BYTES) != hipSuccess || per_cu < 1) { fprintf(stderr, "kernel_launch: occupancy query says %d blocks per CU\n", per_cu); per_cu = 1; }
        (void)hipGetLastError();
        grid = (cus > 0 ? cus : 256);
    }
    if (grid < 0) return;
    Args a{};
    for (int i = 0; i < 33; ++i) a.in[i] = (const float*)d_in[i];
    a.out = (float*)d_out; a.ws = (unsigned char*)d_ws;
    a.ph_lo = 0; a.ph_hi = N_PHASES;
    if (hipMemsetAsync(d_ws, 0, 512 * 1024, stream) != hipSuccess) { fprintf(stderr, "kernel_launch: memset failed\n"); return; }
    void* args[] = {&a};
    hipError_t e = hipLaunchCooperativeKernel((const void*)fwd_kernel<true>, dim3(grid), dim3(NTHREADS), args, LDS_BYTES, stream);
    if (e != hipSuccess) fprintf(stderr, "cooperative launch failed: %s (grid %d)\n", hipGetErrorString(e), grid);
}
```
